# Optimizing an MI355X kernel written in HIP

```python
import jax, jax.numpy as jnp
from jax import lax
import numpy as np

D_MODEL = 2048
BATCH = 8
SEQ = 2048
DEPTH = 2

GRID_W = 64
CTX_LEN = 256
EPS = 1e-6

HEAD_DIM = 128
N_Q_HEADS = D_MODEL // (2 * HEAD_DIM)
N_KV_HEADS = max(1, N_Q_HEADS // 4)
Q_PER_KV = N_Q_HEADS // N_KV_HEADS
ATTN_WIDTH = N_Q_HEADS * HEAD_DIM
KV_WIDTH = N_KV_HEADS * HEAD_DIM
Q_BLOCK = 128
ROPE_THETA = 10000.0
AXIS_DIM = HEAD_DIM // 2

CHUNK = 128
MLP_WIDTH = D_MODEL // 4
MLP_GROUP_W = 128
MLP_GROUPS = MLP_WIDTH // MLP_GROUP_W

LRU_WIDTH = D_MODEL // 4
LRU_BLOCKS = 4
LRU_BLOCK_W = LRU_WIDTH // LRU_BLOCKS
LRU_C = 8.0
CONV_W = 4
CONV_LEFT = 2

MIX_WIDTH = ATTN_WIDTH + MLP_WIDTH + LRU_WIDTH
IN_COLS = ATTN_WIDTH + 2 * KV_WIDTH + 2 * MLP_WIDTH + 2 * LRU_WIDTH
SPLITS = (ATTN_WIDTH,
          ATTN_WIDTH + KV_WIDTH,
          ATTN_WIDTH + 2 * KV_WIDTH,
          ATTN_WIDTH + 2 * KV_WIDTH + 2 * MLP_WIDTH,
          ATTN_WIDTH + 2 * KV_WIDTH + 2 * MLP_WIDTH + LRU_WIDTH)

D_FF = -(-8 * D_MODEL // (3 * 256)) * 256

kernel_name = "hybrid_parallel_heads_dit_block"


def rmsnorm(x, g):
    xf = x.astype(jnp.float32)
    y = xf * lax.rsqrt(jnp.mean(xf * xf, axis=-1, keepdims=True) + EPS)
    return (y * g.astype(jnp.float32)).astype(x.dtype)


def modulate(h, shift, scale):
    return h * (1 + scale) + shift


def axial_rope_tables(n_tokens):
    rows = n_tokens // GRID_W
    row_ids = jnp.repeat(jnp.arange(rows, dtype=jnp.float32), GRID_W)
    col_ids = jnp.tile(jnp.arange(GRID_W, dtype=jnp.float32), rows)
    inv_freq = ROPE_THETA ** (-jnp.arange(0, AXIS_DIM, 2, dtype=jnp.float32) / AXIS_DIM)
    ang_r = row_ids[:, None] * inv_freq
    ang_c = col_ids[:, None] * inv_freq
    ang = jnp.concatenate([ang_r, ang_r, ang_c, ang_c], axis=-1)
    return jnp.cos(ang), jnp.sin(ang)


def apply_axial_rope(x, cos, sin):
    shape = x.shape
    xf = x.astype(jnp.float32)
    xs = xf.reshape(shape[:-1] + (2, 2, AXIS_DIM // 2))
    rot = jnp.stack([-xs[..., 1, :], xs[..., 0, :]], axis=-2).reshape(shape)
    bshape = (shape[1],) + (1,) * (x.ndim - 3) + (HEAD_DIM,)
    return (xf * cos.reshape(bshape) + rot * sin.reshape(bshape)).astype(x.dtype)


def attend(q, k, v):
    s = jnp.einsum('bkgqd,bktd->bkgqt', q, k, preferred_element_type=jnp.float32) * (HEAD_DIM ** -0.5)
    p = jax.nn.softmax(s, axis=-1).astype(v.dtype)
    return jnp.einsum('bkgqt,bktd->bkgqd', p, v)


def chunk_mlp(z, w_s, b_s):
    B, L, _ = z.shape
    u, v = jnp.split(jax.nn.gelu(z), 2, axis=-1)
    vb = v.reshape(B, L // CHUNK, CHUNK, MLP_GROUPS, MLP_GROUP_W)
    s = jnp.einsum('gpq,bnqgc->bnpgc', w_s, vb) + b_s.T[None, None, :, :, None]
    return u * s.reshape(B, L, MLP_WIDTH)


def depthwise_conv(x, w, b):
    L = x.shape[1]
    xp = jnp.pad(x, ((0, 0), (CONV_LEFT, CONV_W - 1 - CONV_LEFT), (0, 0)))
    y = b
    for tap in range(CONV_W):
        y = y + xp[:, tap:tap + L] * w[tap]
    return y


def lru_coeffs(x, w_a, w_x, b_a, b_x, lam):
    B, L, W = x.shape
    xb = x.reshape(B, L, LRU_BLOCKS, LRU_BLOCK_W)
    r = jax.nn.sigmoid((jnp.einsum('blhi,hij->blhj', xb, w_a).reshape(B, L, W) + b_a).astype(jnp.float32))
    i = jax.nn.sigmoid((jnp.einsum('blhi,hij->blhj', xb, w_x).reshape(B, L, W) + b_x).astype(jnp.float32))
    log_a = -LRU_C * jax.nn.softplus(-lam.astype(jnp.float32)) * r
    a = jnp.exp(log_a)
    bx = jnp.sqrt(-jnp.expm1(2.0 * log_a)) * (i * x.astype(jnp.float32))
    return a, bx


def linear_scan(a, bx, h0, reverse):
    def combine(l, r):
        return (l[0] * r[0], r[0] * l[1] + r[1])
    A, Bc = lax.associative_scan(combine, (a, bx), reverse=reverse, axis=1)
    if h0 is None:
        return Bc
    return A * h0[:, None, :] + Bc


def swiglu(h, w_ffn_in, w_ffn_out):
    g, u = jnp.split(h @ w_ffn_in, 2, axis=-1)
    return (jax.nn.silu(g) * u) @ w_ffn_out


def mixer(h, hc, w_in, g_qk, w_s, b_s, conv_w, conv_b, lru_w, lru_b, lru_lam, w_out, cos, sin, ctx_out):
    B, N, _ = h.shape
    C = hc.shape[1]
    q, k, v, zm, zx, zg = jnp.split(h @ w_in, SPLITS, axis=-1)
    qc, kc, vc, zmc, zxc, zgc = jnp.split(hc @ w_in, SPLITS, axis=-1)

    q = apply_axial_rope(rmsnorm(q.reshape(B, N, N_KV_HEADS, Q_PER_KV, HEAD_DIM), g_qk[0]), cos, sin)
    q = q.transpose(0, 2, 3, 1, 4)
    k = apply_axial_rope(rmsnorm(k.reshape(B, N, N_KV_HEADS, HEAD_DIM), g_qk[1]), cos, sin)
    k = k.transpose(0, 2, 1, 3)
    v = v.reshape(B, N, N_KV_HEADS, HEAD_DIM).transpose(0, 2, 1, 3)
    kc = rmsnorm(kc.reshape(B, C, N_KV_HEADS, HEAD_DIM), g_qk[1]).transpose(0, 2, 1, 3)
    vc = vc.reshape(B, C, N_KV_HEADS, HEAD_DIM).transpose(0, 2, 1, 3)
    k_all = jnp.concatenate([kc, k], axis=2)
    v_all = jnp.concatenate([vc, v], axis=2)
    n_blocks = N // Q_BLOCK
    qb = q.reshape(B, N_KV_HEADS, Q_PER_KV, n_blocks, Q_BLOCK, HEAD_DIM).transpose(3, 0, 1, 2, 4, 5)
    o = lax.map(lambda qi: attend(qi, k_all, v_all), qb)
    attn = o.transpose(1, 0, 4, 2, 3, 5).reshape(B, N, ATTN_WIDTH)

    mlp = chunk_mlp(zm, w_s, b_s)

    xr = depthwise_conv(zx, conv_w, conv_b)
    xrc = depthwise_conv(zxc, conv_w, conv_b)
    h_lat, h_ctx = [], []
    for d, rev in ((0, False), (1, True)):
        ac, bcx = lru_coeffs(xrc, lru_w[d, 0], lru_w[d, 1], lru_b[d, 0], lru_b[d, 1], lru_lam[d])
        hcs = linear_scan(ac, bcx, None, rev)
        h0 = hcs[:, 0] if rev else hcs[:, -1]
        al, blx = lru_coeffs(xr, lru_w[d, 0], lru_w[d, 1], lru_b[d, 0], lru_b[d, 1], lru_lam[d])
        h_lat.append(linear_scan(al, blx, h0, rev))
        h_ctx.append(hcs)
    lru = ((h_lat[0] + h_lat[1]) * jax.nn.gelu(zg.astype(jnp.float32))).astype(h.dtype)

    y = jnp.concatenate([attn, mlp, lru], axis=-1) @ w_out
    if not ctx_out:
        return y, None

    qc = rmsnorm(qc.reshape(B, C, N_KV_HEADS, Q_PER_KV, HEAD_DIM), g_qk[0]).transpose(0, 2, 3, 1, 4)
    attn_c = attend(qc, kc, vc).transpose(0, 3, 1, 2, 4).reshape(B, C, ATTN_WIDTH)
    mlp_c = chunk_mlp(zmc, w_s, b_s)
    lru_c = ((h_ctx[0] + h_ctx[1]) * jax.nn.gelu(zgc.astype(jnp.float32))).astype(hc.dtype)
    yc = jnp.concatenate([attn_c, mlp_c, lru_c], axis=-1) @ w_out
    return y, yc


def setup_inputs(seed: int = 0) -> dict:
    key = jax.random.key(seed)
    ks = jax.random.split(key, 24)
    f32 = jnp.float32

    def nrm(k, shape, scale):
        return jax.random.normal(k, shape, f32) * scale

    u = jax.random.uniform(ks[17], (DEPTH, 2, LRU_WIDTH), f32, minval=0.9, maxval=0.999)
    a0 = u ** (1.0 / LRU_C)
    lru_lam = jnp.log(a0) - jnp.log1p(-a0)
    return {
        "x": nrm(ks[0], (BATCH, SEQ, D_MODEL), 1.0),
        "c": nrm(ks[1], (BATCH, D_MODEL), 1.0),
        "ctx": nrm(ks[2], (BATCH, CTX_LEN, D_MODEL), 1.0),
        "c_ctx": nrm(ks[3], (D_MODEL,), 1.0),
        "w_mod": nrm(ks[4], (DEPTH, D_MODEL, 6 * D_MODEL), 0.5 * D_MODEL ** -0.5),
        "b_mod": nrm(ks[5], (DEPTH, 6 * D_MODEL), 0.02),
        "g_norm": 1.0 + nrm(ks[6], (DEPTH, 4, D_MODEL), 0.02),
        "w_in": nrm(ks[7], (DEPTH, D_MODEL, IN_COLS), D_MODEL ** -0.5),
        "g_qk": 1.0 + nrm(ks[8], (DEPTH, 2, HEAD_DIM), 0.02),
        "w_s": nrm(ks[9], (DEPTH, MLP_GROUPS, CHUNK, CHUNK), CHUNK ** -0.5),
        "b_s": nrm(ks[10], (DEPTH, MLP_GROUPS, CHUNK), 0.1),
        "conv_w": nrm(ks[11], (DEPTH, CONV_W, LRU_WIDTH), CONV_W ** -0.5),
        "conv_b": nrm(ks[12], (DEPTH, LRU_WIDTH), 0.02),
        "lru_w": nrm(ks[13], (DEPTH, 2, 2, LRU_BLOCKS, LRU_BLOCK_W, LRU_BLOCK_W), LRU_BLOCK_W ** -0.5),
        "lru_b": nrm(ks[14], (DEPTH, 2, 2, LRU_WIDTH), 0.1),
        "lru_lam": lru_lam,
        "w_out": nrm(ks[15], (DEPTH, MIX_WIDTH, D_MODEL), MIX_WIDTH ** -0.5),
        "w_ffn_in": nrm(ks[16], (DEPTH, D_MODEL, 2 * D_FF), D_MODEL ** -0.5),
        "w_ffn_out": nrm(ks[18], (DEPTH, D_FF, D_MODEL), D_FF ** -0.5),
    }


def reference(x, c, ctx, c_ctx, w_mod, b_mod, g_norm, w_in, g_qk, w_s, b_s, conv_w, conv_b,
              lru_w, lru_b, lru_lam, w_out, w_ffn_in, w_ffn_out):
    cos, sin = axial_rope_tables(x.shape[1])
    c_act = jax.nn.silu(c)
    cc_act = jax.nn.silu(c_ctx)
    xc = ctx
    for l in range(DEPTH):
        last = l == DEPTH - 1
        mod = (c_act @ w_mod[l] + b_mod[l])[:, None, :]
        modc = cc_act @ w_mod[l] + b_mod[l]
        sh1, sc1, gt1, sh2, sc2, gt2 = jnp.split(mod, 6, axis=-1)
        shc1, scc1, gtc1, shc2, scc2, gtc2 = jnp.split(modc, 6, axis=-1)

        h = modulate(rmsnorm(x, g_norm[l, 0]), sh1, sc1)
        hc = modulate(rmsnorm(xc, g_norm[l, 0]), shc1, scc1)
        y, yc = mixer(h, hc, w_in[l], g_qk[l], w_s[l], b_s[l], conv_w[l], conv_b[l],
                      lru_w[l], lru_b[l], lru_lam[l], w_out[l], cos, sin, not last)
        x = x + gt1 * rmsnorm(y, g_norm[l, 1])
        f = swiglu(modulate(rmsnorm(x, g_norm[l, 2]), sh2, sc2), w_ffn_in[l], w_ffn_out[l])
        x = x + gt2 * rmsnorm(f, g_norm[l, 3])

        if not last:
            xc = xc + gtc1 * rmsnorm(yc, g_norm[l, 1])
            fc = swiglu(modulate(rmsnorm(xc, g_norm[l, 2]), shc2, scc2), w_ffn_in[l], w_ffn_out[l])
            xc = xc + gtc2 * rmsnorm(fc, g_norm[l, 3])
    return x
```

```cpp
#include <hip/hip_runtime.h>
#include <hip/hip_bf16.h>
#include <hip/hip_cooperative_groups.h>
#include <cstdio>
#include <cstdint>
namespace cg = cooperative_groups;

#define LAS __attribute__((address_space(3)))
typedef unsigned short bf16_t;
typedef float f32x4_t __attribute__((ext_vector_type(4)));
typedef float f32x2_t __attribute__((ext_vector_type(2)));
typedef unsigned u32x4_t __attribute__((ext_vector_type(4)));
typedef unsigned u32x2_t __attribute__((ext_vector_type(2)));

constexpr int DM = 2048, NB = 8, SEQ = 2048, CTXL = 256, NLAYER = 2;
constexpr int ML = NB * SEQ, MC = NB * CTXL, MT = ML + MC;
constexpr int INC = 3584, DFF = 5632, SKV = CTXL + SEQ;
constexpr int K_OFF = 1024, V_OFF = 1280, ZM_OFF = 1536, ZX_OFF = 2560, ZG_OFF = 3072;
constexpr int NCHUNK = MT / 128;
constexpr float EPS = 1e-6f;

constexpr size_t SZ_WIN = (size_t)INC * DM * 2, SZ_WOUT = (size_t)DM * DM * 2, SZ_WFI = (size_t)2 * DFF * DM * 2, SZ_WFO = (size_t)DM * DFF * 2;
constexpr size_t SZ_LRUW = (size_t)16 * 128 * 128 * 2, SZ_WSB = (size_t)4 * 128 * 128 * 2, SZ_MOD = (size_t)NLAYER * 9 * 6 * DM * 4;
constexpr size_t WS_WIN = 0;
constexpr size_t WS_WOUT = WS_WIN + NLAYER * SZ_WIN;
constexpr size_t WS_WFI = WS_WOUT + NLAYER * SZ_WOUT;
constexpr size_t WS_WFO = WS_WFI + NLAYER * SZ_WFI;
constexpr size_t WS_LRUW = WS_WFO + NLAYER * SZ_WFO;
constexpr size_t WS_WSB = WS_LRUW + NLAYER * SZ_LRUW;
constexpr size_t WS_MOD = WS_WSB + NLAYER * SZ_WSB;
constexpr size_t WS_HBUF = WS_MOD + SZ_MOD;
constexpr size_t WS_PBUF = WS_HBUF + (size_t)MT * DM * 2;
constexpr size_t WS_YBUF = WS_PBUF + (size_t)MT * DFF * 2;
constexpr size_t WS_KBUF = WS_YBUF + (size_t)MT * DM * 4;
constexpr size_t WS_VBUF = WS_KBUF + (size_t)NB * 2 * SKV * 128 * 2;
constexpr size_t WS_XC = WS_VBUF + (size_t)NB * 2 * SKV * 128 * 2;
constexpr size_t WS_AGG = WS_XC + (size_t)MC * DM * 4;
constexpr size_t WS_END = WS_AGG + (size_t)2 * NCHUNK * 512 * 2 * 4;
constexpr int LDS_BYTES = 131072;

__device__ __forceinline__ unsigned pk2bf(float lo, float hi) { unsigned r; asm volatile("v_cvt_pk_bf16_f32 %0, %1, %2" : "=v"(r) : "v"(lo), "v"(hi)); return r; }
__device__ __forceinline__ unsigned short f2bf(float f) { return (unsigned short)(pk2bf(f, 0.f) & 0xffffu); }
__device__ __forceinline__ float bf2f(unsigned short b) { return __uint_as_float(((unsigned)b) << 16); }
__device__ __forceinline__ float bflo(unsigned w) { return __uint_as_float(w << 16); }
__device__ __forceinline__ float bfhi(unsigned w) { return __uint_as_float(w & 0xffff0000u); }
__device__ __forceinline__ float sigmoid_f(float x) { return __builtin_amdgcn_rcpf(1.f + __expf(-x)); }
__device__ __forceinline__ float gelu_tanh(float x) { const float u = 1.5957691216057308f * (x + 0.044715f * x * x * x); return x * sigmoid_f(u); }
__device__ __forceinline__ float wave_sum(float v) {
#pragma unroll
    for (int o = 1; o < 64; o <<= 1) v += __shfl_xor(v, o);
    return v;
}
#define LDS_WAIT() asm volatile("s_waitcnt lgkmcnt(0)" ::: "memory")

namespace pg8 {
#define PG8_LAS __attribute__((address_space(3)))
typedef unsigned short bf16_t;
typedef short bf16x8 __attribute__((ext_vector_type(8)));
typedef float f32x4 __attribute__((ext_vector_type(4)));
typedef unsigned u32x4 __attribute__((ext_vector_type(4)));
constexpr int BM = 256, BK = 64, HALF = 128, HTB = HALF * BK * 2  , STAGE_BYTES = 8 * HTB, NXCD = 8, WGM = 8;

__host__ __device__ __forceinline__ int lds_byte(int r, int c) { const int st = (r >> 4) * 2 + (c >> 5), rr = r & 15, cc = c & 31, ob = rr * 64 + cc * 2; return st * 1024 + (ob ^ (((ob >> 9) & 1) << 5)); }
__host__ __device__ __forceinline__ void stage_rc(int b, int& R, int& C) { const int st = b / 1024, sb = b % 1024, swz = sb ^ (((sb >> 9) & 1) << 5); R = (st >> 1) * 16 + swz / 64; C = (st & 1) * 32 + (swz % 64) / 2; }
__host__ __device__ __forceinline__ int perm32(int rho) { const int n = rho >> 4, i = rho & 15; return 8 * (i >> 2) + 4 * n + (i & 3); }

struct Unit { int pm, pn; };
struct Gemm { const bf16_t* A; const bf16_t* Bt; int M, N, K; };

struct StaticOrder {
    int nM, nN, nwg, G, c;
    __host__ __device__ void init(int M, int N, int G_, int c_) { nM = M / BM; nN = N / BM; nwg = nM * nN; G = G_; c = c_; }
    __host__ __device__ bool next(int i, Unit& u) const {
        const long L = (long)i * G + c; if (L >= nwg) return false;
        int wgid = (int)L; { const int q = nwg / NXCD, r = nwg % NXCD, xcd = wgid % NXCD, off = wgid / NXCD; wgid = (xcd < r ? xcd * (q + 1) : r * (q + 1) + (xcd - r) * q) + off; }
        const int nig = WGM * nN, gid = wgid / nig, fm = gid * WGM, gsz = (nM - fm) < WGM ? (nM - fm) : WGM;
        u.pm = fm + ((wgid % nig) % gsz); u.pn = (wgid % nig) / gsz; return true;
    }
    __device__ __forceinline__ void a_ready(const Unit&) const {}
    __device__ __forceinline__ void done(const Unit&) const {}
};
__device__ __forceinline__ unsigned cvt_pk_bf16(float lo, float hi) { unsigned r; asm volatile("v_cvt_pk_bf16_f32 %0, %1, %2" : "=v"(r) : "v"(lo), "v"(hi)); return r; }
struct EpiF32 {
    static constexpr bool PERM = false, AFTER_DRAIN = false;
    float* C; int ldc;
    __device__ __forceinline__ void operator()(const f32x4 (&acc)[2][2][4][2], const Unit& u, int wr, int wc, int fr, int fq) const {
        const int row0 = u.pm * BM + wr * 64 + fr, col0 = u.pn * BM + wc * 32 + 4 * fq;
#pragma unroll
        for (int ai = 0; ai < 2; ++ai)
#pragma unroll
            for (int m = 0; m < 4; ++m) { float* rowp = C + (size_t)(row0 + ai * HALF + m * 16) * ldc + col0;
#pragma unroll
                for (int bj = 0; bj < 2; ++bj)
#pragma unroll
                    for (int n = 0; n < 2; ++n) *(f32x4*)(rowp + bj * HALF + n * 16) = acc[ai][bj][m][n]; }
    }
};
struct EpiBf16 {
    static constexpr bool PERM = true, AFTER_DRAIN = false;
    bf16_t* O; int ldc;
    __device__ __forceinline__ void operator()(const f32x4 (&acc)[2][2][4][2], const Unit& u, int wr, int wc, int fr, int fq) const {
        const int row0 = u.pm * BM + wr * 64 + fr, col0 = u.pn * BM + wc * 32 + 8 * fq;
#pragma unroll
        for (int ai = 0; ai < 2; ++ai)
#pragma unroll
            for (int m = 0; m < 4; ++m) { bf16_t* rowp = O + (size_t)(row0 + ai * HALF + m * 16) * ldc + col0;
#pragma unroll
                for (int bj = 0; bj < 2; ++bj) { const f32x4 v0 = acc[ai][bj][m][0], v1 = acc[ai][bj][m][1];
                    u32x4 w; w.x = cvt_pk_bf16(v0[0], v0[1]); w.y = cvt_pk_bf16(v0[2], v0[3]); w.z = cvt_pk_bf16(v1[0], v1[1]); w.w = cvt_pk_bf16(v1[2], v1[3]);
                    *(u32x4*)(rowp + bj * HALF) = w; } }
    }
};
struct EpiSwiglu {
    static constexpr bool PERM = true, AFTER_DRAIN = false;
    bf16_t* O; int ldc;
    __device__ __forceinline__ void operator()(const f32x4 (&acc)[2][2][4][2], const Unit& u, int wr, int wc, int fr, int fq) const {
        const int row0 = u.pm * BM + wr * 64 + fr, col0 = u.pn * HALF + wc * 32 + 8 * fq;
#pragma unroll
        for (int ai = 0; ai < 2; ++ai)
#pragma unroll
            for (int m = 0; m < 4; ++m) { bf16_t* rowp = O + (size_t)(row0 + ai * HALF + m * 16) * ldc + col0;
                float v[8];
#pragma unroll
                for (int n = 0; n < 2; ++n)
#pragma unroll
                    for (int j = 0; j < 4; ++j) { const float g = acc[ai][0][m][n][j], uu = acc[ai][1][m][n][j];
                        v[n * 4 + j] = g * __builtin_amdgcn_rcpf(1.f + __expf(-g)) * uu; }
                u32x4 w; w.x = cvt_pk_bf16(v[0], v[1]); w.y = cvt_pk_bf16(v[2], v[3]); w.z = cvt_pk_bf16(v[4], v[5]); w.w = cvt_pk_bf16(v[6], v[7]);
                *(u32x4*)rowp = w; }
    }
};
template <class Epi, class Sched, bool STAMP = false>
__device__ __forceinline__ void gemm_phase(PG8_LAS unsigned char* lds, const Gemm g, const Sched& S, const Epi& E, unsigned long long* stamps) {
    int tid_o = threadIdx.x; asm volatile("" : "+v"(tid_o));
    const int tid = tid_o, wid = __builtin_amdgcn_readfirstlane(tid >> 6), lane = tid & 63, wr = wid >> 2, wc = wid & 3, fr = lane & 15, fq = lane >> 4;
    const int K = g.K, nt = K / BK;
    int ts_lo = 0, ts_hi = 0, nts = 0; const unsigned long long rt_entry = STAMP ? (unsigned long long)wall_clock64() : 0ull;
#define PG8_STAMP() do { if (STAMP && wid == 0 && nts < 64) { const unsigned long long _c = (unsigned long long)clock64(); \
        ts_lo = (lane == nts) ? (int)(unsigned)_c : ts_lo; ts_hi = (lane == nts) ? (int)(unsigned)(_c >> 32) : ts_hi; ++nts; } } while (0)
    PG8_STAMP();
    unsigned voffA[2], voffB[2];
#pragma unroll
    for (int i = 0; i < 2; ++i) { int R, C; stage_rc(tid * 16 + i * 8192, R, C); const int Rb = Epi::PERM ? ((R & ~31) + perm32(R & 31)) : R;
        voffA[i] = (unsigned)(R * K + C) * 2u; voffB[i] = (unsigned)(Rb * K + C) * 2u; }
    const size_t kstep = (size_t)(BK * 2);
    const size_t hstep = (size_t)HALF * K * 2;
    const size_t tstep = 2 * hstep;
    const unsigned ldsw = (unsigned)wid * 1024u;
    const int aoff = lds_byte(wr * 64 + fr, fq * 8), boff = lds_byte(wc * 32 + fr, fq * 8);
#define PG8_SA(b, h) (((b) * 2 + (h)) * HTB)
#define PG8_SB(b, h) ((4 + (b) * 2 + (h)) * HTB)
#define PG8_STAGE(bufoff, gbase, voff) do { _Pragma("unroll") for (int _i = 0; _i < 2; ++_i) \
        __builtin_amdgcn_global_load_lds((const unsigned*)((const char*)(gbase) + (voff)[_i]), (PG8_LAS unsigned*)(lds + (bufoff) + ldsw + _i * 8192), 16, 0, 0); } while (0)
#define PG8_LDA(dst, b, h) do { _Pragma("unroll") for (int m = 0; m < 4; ++m) _Pragma("unroll") for (int k = 0; k < 2; ++k) dst[m][k] = *(const PG8_LAS bf16x8*)(lds + PG8_SA(b, h) + aoff + m * 2048 + k * 1024); } while (0)
#define PG8_LDB(dst, b, h) do { _Pragma("unroll") for (int n = 0; n < 2; ++n) _Pragma("unroll") for (int k = 0; k < 2; ++k) dst[n][k] = *(const PG8_LAS bf16x8*)(lds + PG8_SB(b, h) + boff + n * 2048 + k * 1024); } while (0)
#define PG8_MMA(ai, bj, At, Bt) do { __builtin_amdgcn_s_setprio(1); _Pragma("unroll") for (int m = 0; m < 4; ++m) _Pragma("unroll") for (int n = 0; n < 2; ++n) _Pragma("unroll") for (int k = 0; k < 2; ++k) \
        acc[ai][bj][m][n] = __builtin_amdgcn_mfma_f32_16x16x32_bf16(Bt[n][k], At[m][k], acc[ai][bj][m][n], 0, 0, 0); __builtin_amdgcn_s_setprio(0); } while (0)
#define PG8_WAIT_V(n) asm volatile("s_waitcnt vmcnt(" #n ")" ::: "memory")
#define PG8_WAIT_L(n) asm volatile("s_waitcnt lgkmcnt(" #n ")" ::: "memory")
#define PG8_BAR __builtin_amdgcn_s_barrier()
#define PG8_SCHED __builtin_amdgcn_sched_barrier(0)
    Unit cur, nxt; int ui = 0;
    if (!S.next(0, cur)) return;
    f32x4 acc[2][2][4][2];
#pragma unroll
    for (int a = 0; a < 2; ++a)
#pragma unroll
        for (int b = 0; b < 2; ++b)
#pragma unroll
            for (int m = 0; m < 4; ++m)
#pragma unroll
                for (int n = 0; n < 2; ++n) acc[a][b][m][n] = (f32x4){0.f, 0.f, 0.f, 0.f};
    bf16x8 At[4][2], B0[2][2], B1[2][2];
    const char* cA = (const char*)g.A + (size_t)cur.pm * tstep; const char* cB = (const char*)g.Bt + (size_t)cur.pn * tstep;
    S.a_ready(cur);
    PG8_STAGE(PG8_SB(0, 0), cB, voffB); PG8_STAGE(PG8_SA(0, 0), cA, voffA); PG8_STAGE(PG8_SB(0, 1), cB + hstep, voffB); PG8_STAGE(PG8_SA(0, 1), cA + hstep, voffA);
    if (wr == 1) PG8_BAR;
    PG8_WAIT_V(4); PG8_BAR;
    PG8_STAGE(PG8_SB(1, 0), cB + kstep, voffB); PG8_STAGE(PG8_SA(1, 0), cA + kstep, voffA); PG8_STAGE(PG8_SB(1, 1), cB + hstep + kstep, voffB);
    PG8_WAIT_V(6); PG8_BAR;
    PG8_STAMP();
    for (;;) {
        const bool has_next = S.next(ui + 1, nxt);
        const char* nA = has_next ? (const char*)g.A + (size_t)nxt.pm * tstep : cA; const char* nB = has_next ? (const char*)g.Bt + (size_t)nxt.pn * tstep : cB;
        for (int t = 0; t < nt; t += 2) {
            const bool last = (t == nt - 2);
            const char* a1 = cA + (size_t)(t + 1) * kstep;
            const char* a2 = last ? nA : cA + (size_t)(t + 2) * kstep; const char* b2 = last ? nB : cB + (size_t)(t + 2) * kstep;
            const char* a3 = a2 + kstep; const char* b3 = b2 + kstep;
            if (last && has_next) S.a_ready(nxt);
            PG8_LDB(B0, 0, 0); PG8_SCHED; PG8_LDA(At, 0, 0); PG8_STAGE(PG8_SA(1, 1), a1 + hstep, voffA);
            PG8_WAIT_L(8); PG8_BAR; PG8_WAIT_L(0); PG8_MMA(0, 0, At, B0); PG8_BAR; PG8_SCHED;
            PG8_LDB(B1, 0, 1); PG8_STAGE(PG8_SB(0, 0), b2, voffB);
            PG8_BAR; PG8_WAIT_L(0); PG8_MMA(0, 1, At, B1); PG8_BAR;
            PG8_LDA(At, 0, 1); PG8_STAGE(PG8_SA(0, 0), a2, voffA);
            PG8_BAR; PG8_WAIT_L(0); PG8_MMA(1, 0, At, B0); PG8_BAR; PG8_SCHED;
            PG8_STAGE(PG8_SB(0, 1), b2 + hstep, voffB);
            PG8_WAIT_V(6); PG8_BAR; PG8_MMA(1, 1, At, B1); PG8_BAR;
            PG8_LDB(B0, 1, 0); PG8_SCHED; PG8_LDA(At, 1, 0); PG8_STAGE(PG8_SA(0, 1), a2 + hstep, voffA);
            PG8_WAIT_L(8); PG8_BAR; PG8_WAIT_L(0); PG8_MMA(0, 0, At, B0); PG8_BAR; PG8_SCHED;
            PG8_LDB(B1, 1, 1); PG8_STAGE(PG8_SB(1, 0), b3, voffB);
            PG8_BAR; PG8_WAIT_L(0); PG8_MMA(0, 1, At, B1); PG8_BAR;
            PG8_LDA(At, 1, 1); PG8_STAGE(PG8_SA(1, 0), a3, voffA);
            PG8_BAR; PG8_WAIT_L(0); PG8_MMA(1, 0, At, B0); PG8_BAR; PG8_SCHED;
            PG8_STAGE(PG8_SB(1, 1), b3 + hstep, voffB);
            PG8_WAIT_V(6); PG8_BAR; PG8_MMA(1, 1, At, B1); PG8_BAR;
        }
        PG8_STAMP();
        if constexpr (!Epi::AFTER_DRAIN) { E(acc, cur, wr, wc, fr, fq); S.done(cur); }
        PG8_STAMP();
        if (!has_next) break;
#pragma unroll
        for (int a = 0; a < 2; ++a)
#pragma unroll
            for (int b = 0; b < 2; ++b)
#pragma unroll
                for (int m = 0; m < 4; ++m)
#pragma unroll
                    for (int n = 0; n < 2; ++n) acc[a][b][m][n] = (f32x4){0.f, 0.f, 0.f, 0.f};
        cur = nxt; cA = nA; cB = nB; ++ui;
    }
    PG8_WAIT_V(0);
    if (wr == 0) PG8_BAR;
    PG8_BAR;
    if constexpr (Epi::AFTER_DRAIN) { E.fused(acc, cur, wr, wc, fr, fq, lds, wid, lane); S.done(cur); }
    PG8_STAMP();
    if (STAMP && wid == 0) { stamps[lane] = lane < nts ? (((unsigned long long)(unsigned)ts_hi << 32) | (unsigned)ts_lo) : 0ull;
        if (lane == 62) stamps[62] = rt_entry; if (lane == 63) stamps[63] = (unsigned long long)wall_clock64(); }
#undef PG8_STAMP
#undef PG8_SA
#undef PG8_SB
#undef PG8_STAGE
#undef PG8_LDA
#undef PG8_LDB
#undef PG8_MMA
#undef PG8_WAIT_V
#undef PG8_WAIT_L
#undef PG8_BAR
#undef PG8_SCHED
}
}

using bf16 = __hip_bfloat16;
constexpr int   D = 128, NW = 8, QBLK = 32, KVBLK = 64;
constexpr float SCALE = 0.088388347648318440f;
constexpr float THR = 8.f;
#ifndef ATT_SDEPTH
#define ATT_SDEPTH 1
#endif
constexpr int SDEPTH = ATT_SDEPTH;
constexpr int LDQ = INC, LDK = 128, LDO = DM;
constexpr size_t SHM_V = KVBLK * D * 2, SHM_K = KVBLK * D * 2, SHM_ATTN = 2 * SHM_V + 2 * SHM_K + NW * 64 * 4;
using bf16x8 = __attribute__((ext_vector_type(8))) short;
using s16x4  = __attribute__((ext_vector_type(4))) short;
using f32x16 = __attribute__((ext_vector_type(16))) float;
using f32x8  = __attribute__((ext_vector_type(8))) float;
using u32x4  = __attribute__((ext_vector_type(4))) unsigned;
#define KSWZ(row, colB) ((row) * 256 + ((colB) ^ (((row) & 7) << 4)))
#define SBAR() __builtin_amdgcn_sched_barrier(0)
__device__ __forceinline__ int crow(int r, int hi) { return (r & 3) + 8 * (r >> 2) + 4 * hi; }
__device__ __forceinline__ unsigned cvtpk(float lo, float hi) {
  unsigned r; asm volatile("v_cvt_pk_bf16_f32 %0, %1, %2" : "=v"(r) : "v"(lo), "v"(hi)); return r;
}
template <typename TIn> struct Stage;
template <> struct Stage<bf16>  { using T = bf16x8;
  __device__ static __forceinline__ T ld8(const bf16* p) { return *reinterpret_cast<const bf16x8*>(p); }
  __device__ static __forceinline__ bf16x8 tobf(T x) { return x; } };
template <> struct Stage<float> { using T = f32x8;
  __device__ static __forceinline__ T ld8(const float* p) { return *reinterpret_cast<const f32x8*>(p); }
  __device__ static __forceinline__ bf16x8 tobf(T x) {
    u32x4 w = {cvtpk(x[0], x[1]), cvtpk(x[2], x[3]), cvtpk(x[4], x[5]), cvtpk(x[6], x[7])}; return *reinterpret_cast<bf16x8*>(&w); } };

__device__ __forceinline__ void partialSM(f32x16& p0, f32x16& p1, float& m_reg, float& mn, float& alpha) {
  constexpr float C = SCALE * 1.4426950408889634f;
  float pmax = p0[0]; for (int r = 1; r < 16; ++r) pmax = fmaxf(pmax, p0[r]); for (int r = 0; r < 16; ++r) pmax = fmaxf(pmax, p1[r]);
  { auto rr = __builtin_amdgcn_permlane32_swap(__float_as_uint(pmax), __float_as_uint(pmax), false, false);
    pmax = fmaxf(__uint_as_float(rr[0]), __uint_as_float(rr[1])); }
  if (__builtin_expect(__all(pmax - m_reg <= THR / SCALE), 1)) { mn = m_reg; alpha = 1.f; }
  else { mn = fmaxf(m_reg, pmax); alpha = __builtin_amdgcn_exp2f((m_reg - mn) * C); m_reg = mn; }
  float mnC = -mn * C;
  for (int r = 0; r < 16; ++r) p0[r] = fmaf(p0[r], C, mnC); for (int r = 0; r < 16; ++r) p1[r] = fmaf(p1[r], C, mnC);
  for (int r = 0; r < 16; ++r) p0[r] = __builtin_amdgcn_exp2f(p0[r]);
}
__device__ __forceinline__ void finishSM(f32x16& p0, f32x16& p1, float alpha, float& l_reg, bf16x8& pa0, bf16x8& pa1, bf16x8& pa2, bf16x8& pa3) {
  for (int r = 0; r < 16; ++r) p1[r] = __builtin_amdgcn_exp2f(p1[r]);
  float ps = 0; for (int r = 0; r < 16; ++r) ps += p0[r]; for (int r = 0; r < 16; ++r) ps += p1[r];
  { auto rr = __builtin_amdgcn_permlane32_swap(__float_as_uint(ps), __float_as_uint(ps), false, false);
    ps = __uint_as_float(rr[0]) + __uint_as_float(rr[1]); }
  l_reg = l_reg * alpha + ps;
#define PK4(P, BASE, OUT) do { unsigned a0 = cvtpk(P[BASE + 0], P[BASE + 1]), a1 = cvtpk(P[BASE + 2], P[BASE + 3]);   \
    unsigned b0 = cvtpk(P[BASE + 4], P[BASE + 5]), b1 = cvtpk(P[BASE + 6], P[BASE + 7]);                              \
    auto r0 = __builtin_amdgcn_permlane32_swap(a0, b0, false, false); auto r1 = __builtin_amdgcn_permlane32_swap(a1, b1, false, false); \
    u32x4 w = {r0[0], r1[0], r0[1], r1[1]}; OUT = *reinterpret_cast<bf16x8*>(&w); } while (0)
  PK4(p0, 0, pa0); PK4(p0, 8, pa1); PK4(p1, 0, pa2); PK4(p1, 8, pa3);
#undef PK4
}
__device__ __forceinline__ void qkt(f32x16& p0, f32x16& p1, const bf16* Ks, const bf16x8* qr, int r32, int hi) {
  p0 = f32x16{}; p1 = f32x16{};
  for (int d0 = 0; d0 < 8; ++d0) { int cb = (d0 * 16 + hi * 8) * 2;
    bf16x8 b0 = *reinterpret_cast<const bf16x8*>((const char*)Ks + KSWZ(r32, cb));
    bf16x8 b1 = *reinterpret_cast<const bf16x8*>((const char*)Ks + KSWZ(32 + r32, cb));
    p0 = __builtin_amdgcn_mfma_f32_32x32x16_bf16(b0, qr[d0], p0, 0, 0, 0);
    p1 = __builtin_amdgcn_mfma_f32_32x32x16_bf16(b1, qr[d0], p1, 0, 0, 0); }
}
__device__ __forceinline__ int v_st(int k, int c) { const int kk = (k & ~0xC) | ((k & 4) << 1) | ((k & 8) >> 1); return ((kk >> 3) * 4 + (c >> 5)) * 512 + ((kk & 7) * 32 + (c & 31)) * 2; }
__device__ __forceinline__ int v_rd_base(int lane) { return ((lane & 3) << 3) | (((lane >> 2) & 3) << 6) | (((lane >> 4) & 1) << 5) | (((lane >> 5) & 1) << 8); }
constexpr int v_rd_off(int d0, int ks, int half) { return d0 * 512 + ks * 4096 + half * 2048; }
template <int OFF> __device__ __forceinline__ s16x4 tr_read(int vb) {
  s16x4 r; asm volatile("ds_read_b64_tr_b16 %0, %1 offset:%2" : "=&v"(r) : "v"(vb), "i"(OFF) : "memory"); return r;
}
template <int D0> __device__ __forceinline__ void pv_one(f32x16& od, int vb, bf16x8 pa0, bf16x8 pa1, bf16x8 pa2, bf16x8 pa3) {
  const s16x4 l0 = tr_read<v_rd_off(D0, 0, 0)>(vb), h0 = tr_read<v_rd_off(D0, 0, 1)>(vb), l1 = tr_read<v_rd_off(D0, 1, 0)>(vb), h1 = tr_read<v_rd_off(D0, 1, 1)>(vb);
  const s16x4 l2 = tr_read<v_rd_off(D0, 2, 0)>(vb), h2 = tr_read<v_rd_off(D0, 2, 1)>(vb), l3 = tr_read<v_rd_off(D0, 3, 0)>(vb), h3 = tr_read<v_rd_off(D0, 3, 1)>(vb);
  asm volatile("s_waitcnt lgkmcnt(0)" ::: "memory"); SBAR();
#define PK(L, H) (bf16x8){L[0], L[1], L[2], L[3], H[0], H[1], H[2], H[3]}
  od = __builtin_amdgcn_mfma_f32_32x32x16_bf16(pa0, PK(l0, h0), od, 0, 0, 0);
  od = __builtin_amdgcn_mfma_f32_32x32x16_bf16(pa1, PK(l1, h1), od, 0, 0, 0);
  od = __builtin_amdgcn_mfma_f32_32x32x16_bf16(pa2, PK(l2, h2), od, 0, 0, 0);
  od = __builtin_amdgcn_mfma_f32_32x32x16_bf16(pa3, PK(l3, h3), od, 0, 0, 0);
#undef PK
}
__device__ __forceinline__ void pv_d0(f32x16* o, int vb, bf16x8 pa0, bf16x8 pa1, bf16x8 pa2, bf16x8 pa3) {
  pv_one<0>(o[0], vb, pa0, pa1, pa2, pa3); pv_one<1>(o[1], vb, pa0, pa1, pa2, pa3); pv_one<2>(o[2], vb, pa0, pa1, pa2, pa3); pv_one<3>(o[3], vb, pa0, pa1, pa2, pa3);
}

template <typename TQ>
__device__ __forceinline__ void attn_dense_body(const TQ* __restrict__ Qb, const bf16* __restrict__ Kh, const bf16* __restrict__ Vh,
                                                unsigned short* __restrict__ Ob, int seq, char* lds) {
  using St = Stage<bf16>; using SQ = Stage<TQ>;
  int tid_o = threadIdx.x; asm volatile("" : "+v"(tid_o));
  const int tid = tid_o, wid = tid >> 6, lane = tid & 63, r32 = lane & 31, hi = lane >> 5;
  bf16* V_lds = (bf16*)lds; bf16* K_lds = (bf16*)(lds + 2 * SHM_V);
  float* ws = (float*)(lds + 2 * SHM_V + 2 * SHM_K) + wid * 64; float* li_l = ws; float* al_l = ws + 32;
  float m_reg = -1e30f, l_reg = 0; f32x16 o[4] = {}; bf16x8 qr[8];
  const TQ* Qw = Qb + (long)(wid * QBLK + r32) * LDQ + hi * 8;
#pragma unroll
  for (int d0 = 0; d0 < 8; ++d0) qr[d0] = SQ::tobf(SQ::ld8(Qw + d0 * 16));
  const int sr = tid >> 4, sc = (tid & 15) * 8, vst0 = v_st(sr, sc), vst1 = v_st(32 + sr, sc);
  const int vb0 = (int)(uintptr_t)V_lds + v_rd_base(lane);
  struct { typename St::T vs0, vs1, ks0, ks1; } sr_[SDEPTH];
#define SLOAD(i, k0) do { sr_[i].vs0 = St::ld8(&Vh[(long)((k0) + sr) * LDK + sc]); sr_[i].vs1 = St::ld8(&Vh[(long)((k0) + 32 + sr) * LDK + sc]); \
    sr_[i].ks0 = St::ld8(&Kh[(long)((k0) + sr) * LDK + sc]); sr_[i].ks1 = St::ld8(&Kh[(long)((k0) + 32 + sr) * LDK + sc]); } while (0)
#define SWRITE(b, i) do { *(bf16x8*)((char*)V_lds + (b) * SHM_V + vst0) = St::tobf(sr_[i].vs0);          \
    *(bf16x8*)((char*)V_lds + (b) * SHM_V + vst1) = St::tobf(sr_[i].vs1); int kc = sc * 2;               \
    *(bf16x8*)((char*)K_lds + (b) * SHM_K + KSWZ(sr, kc)) = St::tobf(sr_[i].ks0);                       \
    *(bf16x8*)((char*)K_lds + (b) * SHM_K + KSWZ(32 + sr, kc)) = St::tobf(sr_[i].ks1); } while (0)
#define SWAIT() do { if constexpr (SDEPTH == 2) asm volatile("s_waitcnt vmcnt(4)" ::: "memory"); else asm volatile("s_waitcnt vmcnt(0)" ::: "memory"); } while (0)
#define RESC(a) do { if (__any((a) < 1.f)) { if (hi == 0) al_l[r32] = (a); asm volatile("s_waitcnt lgkmcnt(0)" ::: "memory"); \
    for (int d = 0; d < 4; ++d) for (int r = 0; r < 16; ++r) o[d][r] *= al_l[crow(r, hi)]; } } while (0)
  f32x16 pA0, pA1, pB0, pB1; float mnA, mnB, alA, alB; bf16x8 pa0, pa1, pa2, pa3; const int NT = seq / KVBLK;
  constexpr int SE = 0, SO = SDEPTH - 1;
  SLOAD(SE, 0); asm volatile("s_waitcnt vmcnt(0)" ::: "memory"); SWRITE(0, SE); __syncthreads();
  qkt(pA0, pA1, K_lds, qr, r32, hi); partialSM(pA0, pA1, m_reg, mnA, alA);
  SLOAD(SO, KVBLK); if constexpr (SDEPTH == 2) { if (2 < NT) SLOAD(SE, 2 * KVBLK); }
  SWAIT(); SWRITE(1, SO); __syncthreads();
  for (int j = 1; j + 1 < NT; j += 2) {
    SBAR(); qkt(pB0, pB1, (bf16*)((char*)K_lds + SHM_K), qr, r32, hi);
    finishSM(pA0, pA1, alA, l_reg, pa0, pa1, pa2, pa3); SBAR();
    SLOAD(SO, (j + SDEPTH) * KVBLK); SBAR();
    pv_d0(o, vb0, pa0, pa1, pa2, pa3); partialSM(pB0, pB1, m_reg, mnB, alB);
    __syncthreads(); SWAIT(); SWRITE(0, SE);
    RESC(alB); __syncthreads();
    SBAR(); qkt(pA0, pA1, K_lds, qr, r32, hi);
    finishSM(pB0, pB1, alB, l_reg, pa0, pa1, pa2, pa3); SBAR();
    if (SDEPTH == 1 || j + 3 < NT) SLOAD(SE, (j + 1 + SDEPTH) * KVBLK); SBAR();
    pv_d0(o, vb0 + (int)SHM_V, pa0, pa1, pa2, pa3); partialSM(pA0, pA1, m_reg, mnA, alA);
    __syncthreads(); SWAIT(); SWRITE(1, SO);
    RESC(alA); __syncthreads();
  }
  SBAR(); qkt(pB0, pB1, (bf16*)((char*)K_lds + SHM_K), qr, r32, hi);
  finishSM(pA0, pA1, alA, l_reg, pa0, pa1, pa2, pa3); SBAR();
  pv_d0(o, vb0, pa0, pa1, pa2, pa3); partialSM(pB0, pB1, m_reg, mnB, alB);
  __syncthreads(); RESC(alB);
  finishSM(pB0, pB1, alB, l_reg, pa0, pa1, pa2, pa3); SBAR();
  pv_d0(o, vb0 + (int)SHM_V, pa0, pa1, pa2, pa3);
  if (hi == 0) li_l[r32] = l_reg; asm volatile("s_waitcnt lgkmcnt(0)" ::: "memory");
  float rli[16];
#pragma unroll
  for (int r = 0; r < 16; ++r) rli[r] = __builtin_amdgcn_rcpf(li_l[crow(r, hi)]);
  unsigned short* Ow = Ob + (long)(wid * QBLK) * LDO;
#pragma unroll
  for (int r = 0; r < 16; ++r) { int orow = crow(r, hi);
    for (int d0 = 0; d0 < 4; ++d0) Ow[(long)orow * LDO + d0 * 32 + r32] = f2bf(o[d0][r] * rli[r]); }
#undef SLOAD
#undef SWRITE
#undef SWAIT
#undef RESC
}

typedef short bf16x8_t __attribute__((ext_vector_type(8)));
struct Params { const float* in[19]; float* out; unsigned char* ws; };
enum { I_X = 0, I_C, I_CTX, I_CCTX, I_WMOD, I_BMOD, I_GNORM, I_WIN, I_GQK, I_WS, I_BS, I_CONVW, I_CONVB, I_LRUW, I_LRUB, I_LRULAM, I_WOUT, I_WFI, I_WFO };

__device__ __forceinline__ void transpose_item(const float* __restrict__ W, int ldw, bf16_t* __restrict__ dst, int ldk, LAS float* scr, int lane) {
#pragma unroll 8
    for (int i = 0; i < 32; ++i) { const int kk = 2 * i + (lane >> 5); scr[kk * 33 + (lane & 31)] = W[(size_t)kk * ldw + (lane & 31)]; }
    LDS_WAIT();
    const int c = lane & 7;
#pragma unroll
    for (int j = 0; j < 4; ++j) { const int n = (lane >> 3) + 8 * j; const LAS float* s = scr + (8 * c) * 33 + n;
        u32x4_t o; o.x = pk2bf(s[0 * 33], s[1 * 33]); o.y = pk2bf(s[2 * 33], s[3 * 33]); o.z = pk2bf(s[4 * 33], s[5 * 33]); o.w = pk2bf(s[6 * 33], s[7 * 33]);
        *(u32x4_t*)(dst + (size_t)n * ldk + 8 * c) = o; }
    LDS_WAIT();
}

__device__ __forceinline__ void mod_item(int it, const Params& p, LAS float* lds, int tid, int wid, int lane) {
    const int l = it / 96, cgp = it % 96;
    const float* cv = p.in[I_C]; const float* cc = p.in[I_CCTX];
    for (int e = tid; e < 9 * DM; e += 512) { const int r = e >> 11, k = e & (DM - 1); const float v = r < 8 ? cv[r * DM + k] : cc[k]; lds[k * 12 + r] = v * sigmoid_f(v); }
    __syncthreads();
    const float* W = p.in[I_WMOD] + (size_t)l * DM * (6 * DM) + cgp * 128 + lane * 2;
    float acc[9][2];
#pragma unroll
    for (int r = 0; r < 9; ++r) { acc[r][0] = 0.f; acc[r][1] = 0.f; }
    const int kb = wid * 256;
#pragma unroll 8
    for (int k = 0; k < 256; ++k) {
        const f32x2_t w = *(const f32x2_t*)(W + (size_t)(kb + k) * (6 * DM));
        const LAS float* a = lds + (kb + k) * 12;
        const f32x4_t a0 = *(const LAS f32x4_t*)a, a1 = *(const LAS f32x4_t*)(a + 4); const float a8 = a[8];
        acc[0][0] += a0.x * w.x; acc[0][1] += a0.x * w.y; acc[1][0] += a0.y * w.x; acc[1][1] += a0.y * w.y;
        acc[2][0] += a0.z * w.x; acc[2][1] += a0.z * w.y; acc[3][0] += a0.w * w.x; acc[3][1] += a0.w * w.y;
        acc[4][0] += a1.x * w.x; acc[4][1] += a1.x * w.y; acc[5][0] += a1.y * w.x; acc[5][1] += a1.y * w.y;
        acc[6][0] += a1.z * w.x; acc[6][1] += a1.z * w.y; acc[7][0] += a1.w * w.x; acc[7][1] += a1.w * w.y;
        acc[8][0] += a8 * w.x; acc[8][1] += a8 * w.y;
    }
    __syncthreads();
#pragma unroll
    for (int r = 0; r < 9; ++r) { lds[(wid * 18 + r * 2 + 0) * 64 + lane] = acc[r][0]; lds[(wid * 18 + r * 2 + 1) * 64 + lane] = acc[r][1]; }
    __syncthreads();
    float* MOD = (float*)(p.ws + WS_MOD);
    for (int o = tid; o < 9 * 128; o += 512) { const int r = o >> 7, col = o & 127, q = r * 2 + (col & 1), ls = col >> 1;
        float s = p.in[I_BMOD][l * (6 * DM) + cgp * 128 + col];
#pragma unroll
        for (int w = 0; w < 8; ++w) s += lds[(w * 18 + q) * 64 + ls];
        MOD[(size_t)(l * 9 + r) * (6 * DM) + cgp * 128 + col] = s; }
    __syncthreads();
}

__device__ __forceinline__ void phase0(const Params& p, LAS unsigned char* lds, int tid, int wid, int lane) {
    for (int it = blockIdx.x; it < 192; it += gridDim.x) mod_item(it, p, (LAS float*)lds, tid, wid, lane);
    LAS float* scr = (LAS float*)lds + wid * (64 * 33);
    const int gw = blockIdx.x * 8 + wid, NGW = gridDim.x * 8;
    constexpr int NI_WIN = 32 * 112, NI_WOUT = 32 * 64, NI_WFI = 32 * 352, NI_WFO = 88 * 64, NI_LRU = 128, PL = NI_WIN + NI_WOUT + NI_WFI + NI_WFO + NI_LRU;
    for (int it = gw; it < NLAYER * PL; it += NGW) {
        const int l = it / PL; int r = it - l * PL;
        const float* src; bf16_t* dst; int ldw, ldk;
        if (r < NI_WIN) { const int kb = r / 112, nb = r % 112; ldw = INC; ldk = DM;
            src = p.in[I_WIN] + (size_t)l * DM * INC + (size_t)(64 * kb) * INC + 32 * nb;
            dst = (bf16_t*)(p.ws + WS_WIN + l * SZ_WIN) + (size_t)(32 * nb) * DM + 64 * kb; }
        else if ((r -= NI_WIN) < NI_WOUT) { const int kb = r / 64, nb = r % 64; ldw = DM; ldk = DM;
            src = p.in[I_WOUT] + (size_t)l * DM * DM + (size_t)(64 * kb) * DM + 32 * nb;
            dst = (bf16_t*)(p.ws + WS_WOUT + l * SZ_WOUT) + (size_t)(32 * nb) * DM + 64 * kb; }
        else if ((r -= NI_WOUT) < NI_WFI) { const int kb = r / 352, nb = r % 352; ldw = 2 * DFF; ldk = DM;
            const int n0 = 32 * nb, half = n0 / DFF, idx = n0 - half * DFF, drow = (idx >> 7) * 256 + half * 128 + (idx & 127);
            src = p.in[I_WFI] + (size_t)l * DM * 2 * DFF + (size_t)(64 * kb) * (2 * DFF) + n0;
            dst = (bf16_t*)(p.ws + WS_WFI + l * SZ_WFI) + (size_t)drow * DM + 64 * kb; }
        else if ((r -= NI_WFI) < NI_WFO) { const int kb = r / 64, nb = r % 64; ldw = DM; ldk = DFF;
            src = p.in[I_WFO] + (size_t)l * DFF * DM + (size_t)(64 * kb) * DM + 32 * nb;
            dst = (bf16_t*)(p.ws + WS_WFO + l * SZ_WFO) + (size_t)(32 * nb) * DFF + 64 * kb; }
        else { r -= NI_WFO; const int mat = r >> 3, sub = r & 7, kb = sub >> 2, nb = sub & 3; ldw = 128; ldk = 128;
            src = p.in[I_LRUW] + (size_t)(l * 16 + mat) * 16384 + (size_t)(64 * kb) * 128 + 32 * nb;
            dst = (bf16_t*)(p.ws + WS_LRUW + l * SZ_LRUW) + (size_t)mat * 16384 + (size_t)(32 * nb) * 128 + 64 * kb; }
        transpose_item(src, ldw, dst, ldk, scr, lane);
    }
    bf16_t* WSB = (bf16_t*)(p.ws + WS_WSB);
    for (int i = blockIdx.x * 512 + tid; i < NLAYER * 4 * 128 * 128; i += gridDim.x * 512) WSB[i] = f2bf(p.in[I_WS][i]);
}

__device__ __forceinline__ void load_row(const float* rp, int lane, f32x4_t (&v)[8]) {
    const f32x4_t* q = (const f32x4_t*)rp + lane;
#pragma unroll
    for (int j = 0; j < 8; ++j) v[j] = q[64 * j];
}
__device__ __forceinline__ float row_rstd(const f32x4_t (&v)[8]) {
    float s = 0.f;
#pragma unroll
    for (int j = 0; j < 8; ++j) s += (v[j].x * v[j].x + v[j].y * v[j].y) + (v[j].z * v[j].z + v[j].w * v[j].w);
    return rsqrtf(wave_sum(s) * (1.f / DM) + EPS);
}
__device__ __forceinline__ void mod_store(const f32x4_t (&v)[8], float r, const float* g, const float* sh, const float* sc, bf16_t* dst, int lane) {
#pragma unroll
    for (int j = 0; j < 8; ++j) { const int col = 4 * (64 * j + lane);
        const f32x4_t g4 = *(const f32x4_t*)(g + col), sh4 = *(const f32x4_t*)(sh + col), sc4 = *(const f32x4_t*)(sc + col);
        const f32x4_t h = (v[j] * r * g4) * (1.f + sc4) + sh4;
        u32x2_t w; w.x = pk2bf(h.x, h.y); w.y = pk2bf(h.z, h.w);
        *(u32x2_t*)(dst + col) = w; }
}
__device__ __forceinline__ void phaseA(const Params& p, int gw, int NGW, int lane) {
    const float* MOD = (const float*)(p.ws + WS_MOD); bf16_t* H = (bf16_t*)(p.ws + WS_HBUF);
    for (int m = gw; m < MT; m += NGW) {
        const bool lat = m < ML; const int bi = lat ? (m >> 11) : 8;
        const float* xr = lat ? p.in[I_X] + (size_t)m * DM : p.in[I_CTX] + (size_t)(m - ML) * DM;
        f32x4_t v[8]; load_row(xr, lane, v);
        const float r = row_rstd(v);
        const float* md = MOD + (size_t)bi * (6 * DM);
        mod_store(v, r, p.in[I_GNORM], md, md + DM, H + (size_t)m * DM, lane);
    }
}
__device__ __forceinline__ void row_update(const Params& p, int mcount, const float* xs_lat, const float* xs_ctx, float* xd_lat, float* xd_ctx,
                                           const float* modl, int gt_off, const float* gy, bool do_next, const float* gnext, const float* modn, int sh_off, int sc_off,
                                           int gw, int NGW, int lane) {
    const float* Y = (const float*)(p.ws + WS_YBUF); bf16_t* H = (bf16_t*)(p.ws + WS_HBUF);
    for (int m = gw; m < mcount; m += NGW) {
        const bool lat = m < ML; const int bi = lat ? (m >> 11) : 8;
        const float* xs = lat ? xs_lat + (size_t)m * DM : xs_ctx + (size_t)(m - ML) * DM;
        float* xd = lat ? xd_lat + (size_t)m * DM : xd_ctx + (size_t)(m - ML) * DM;
        f32x4_t y[8], x[8]; load_row(Y + (size_t)m * DM, lane, y); load_row(xs, lane, x);
        const float ry = row_rstd(y);
        const float* gt = modl + (size_t)bi * (6 * DM) + gt_off;
#pragma unroll
        for (int j = 0; j < 8; ++j) { const int col = 4 * (64 * j + lane);
            const f32x4_t gt4 = *(const f32x4_t*)(gt + col), g4 = *(const f32x4_t*)(gy + col);
            x[j] = x[j] + gt4 * (y[j] * ry * g4);
            *(f32x4_t*)(xd + col) = x[j]; }
        if (do_next) { const float rx = row_rstd(x); const float* mn = modn + (size_t)bi * (6 * DM);
            mod_store(x, rx, gnext, mn + sh_off, mn + sc_off, H + (size_t)m * DM, lane); }
    }
}

__device__ __forceinline__ void qk_rows(const Params& p, int l, int gw, int NGW, int lane) {
    bf16_t* P = (bf16_t*)(p.ws + WS_PBUF); bf16_t* KB = (bf16_t*)(p.ws + WS_KBUF); bf16_t* VB = (bf16_t*)(p.ws + WS_VBUF);
    const float* gqk = p.in[I_GQK] + l * 256;
    const int a = lane >> 5, i = lane & 31, e0i = a * 64 + i, e1i = e0i + 32;
    const float inv_freq = exp2f(-(float)(2 * i) * (13.287712379549449f / 64.f));
    const float gq0 = gqk[e0i], gq1 = gqk[e1i], gk0 = gqk[128 + e0i], gk1 = gqk[128 + e1i];
    for (int m = gw; m < MT; m += NGW) {
        const bool lat = m < ML; int b, keypos; float cs = 1.f, sn = 0.f;
        if (lat) { b = m >> 11; const int n = m & (SEQ - 1); keypos = CTXL + n;
            const float pos = (float)(a == 0 ? (n >> 6) : (n & 63)); const float ang = pos * inv_freq;
            const float kf = rintf(ang * 0.15915494309189535f); float rr = fmaf(-kf, 6.2831854820251465f, ang); rr = fmaf(-kf, -1.7484555e-7f, rr);
            cs = __cosf(rr); sn = __sinf(rr); }
        else { const int mc = m - ML; b = mc >> 8; keypos = mc & (CTXL - 1); }
        bf16_t* pr = P + (size_t)m * INC;
#pragma unroll
        for (int hd = 0; hd < 10; ++hd) {
            const int col0 = hd < 8 ? hd * 128 : K_OFF + (hd - 8) * 128;
            const float x0 = bf2f(pr[col0 + e0i]), x1 = bf2f(pr[col0 + e1i]);
            const float rs = rsqrtf(wave_sum(x0 * x0 + x1 * x1) * (1.f / 128.f) + EPS);
            const float y0 = x0 * rs * (hd < 8 ? gq0 : gk0), y1 = x1 * rs * (hd < 8 ? gq1 : gk1);
            const float o0 = y0 * cs - y1 * sn, o1 = y1 * cs + y0 * sn;
            if (hd < 8) { pr[col0 + e0i] = f2bf(o0); pr[col0 + e1i] = f2bf(o1); }
            else { bf16_t* kd = KB + ((size_t)(b * 2 + (hd - 8)) * SKV + keypos) * 128; kd[e0i] = f2bf(o0); kd[e1i] = f2bf(o1); }
        }
        { const int hv = lane >> 5, wi = (lane & 31) * 4;
          const u32x2_t w = *(const u32x2_t*)(pr + V_OFF + hv * 128 + wi);
          *(u32x2_t*)(VB + ((size_t)(b * 2 + hv) * SKV + keypos) * 128 + wi) = w; }
    }
}

constexpr int TS = 136;
__device__ __forceinline__ void tile_mma(f32x4_t (&acc)[8], const LAS bf16_t* X, const LAS bf16_t* Y, int wid, int fr, int fq) {
#pragma unroll
    for (int kk = 0; kk < 4; ++kk) {
        const bf16x8_t av = *(const LAS bf16x8_t*)(X + (16 * wid + fr) * TS + kk * 32 + fq * 8);
#pragma unroll
        for (int jb = 0; jb < 8; ++jb) { const bf16x8_t bv = *(const LAS bf16x8_t*)(Y + (16 * jb + fr) * TS + kk * 32 + fq * 8);
            acc[jb] = __builtin_amdgcn_mfma_f32_16x16x32_bf16(av, bv, acc[jb], 0, 0, 0); }
    }
}
__device__ __forceinline__ void stage_tile(LAS bf16_t* T, const bf16_t* src, int ld, int tid) {
#pragma unroll
    for (int q = 0; q < 4; ++q) { const int idx = tid + 512 * q, row = idx >> 4, c8 = (idx & 15) * 8;
        *(LAS u32x4_t*)(T + row * TS + c8) = *(const u32x4_t*)(src + (size_t)row * ld + c8); }
}

__device__ __forceinline__ void mlp_item(const Params& p, int l, int ck, int g, LAS unsigned char* lds, int tid, int wid, int lane) {
    const bf16_t* P = (const bf16_t*)(p.ws + WS_PBUF); bf16_t* H = (bf16_t*)(p.ws + WS_HBUF);
    LAS bf16_t* X = (LAS bf16_t*)lds; LAS bf16_t* Y = X + 128 * TS;
    const int row0 = ck * 128, fr = lane & 15, fq = lane >> 4;
    stage_tile(X, (const bf16_t*)(p.ws + WS_WSB) + (size_t)(l * 4 + g) * 16384, 128, tid);
#pragma unroll
    for (int q4 = 0; q4 < 4; ++q4) { const int idx = tid + 512 * q4, q = idx >> 4, c8 = (idx & 15) * 8;
        const u32x4_t w = *(const u32x4_t*)(P + (size_t)(row0 + q) * INC + (ZM_OFF + 512) + g * 128 + c8);
        Y[(c8 + 0) * TS + q] = f2bf(gelu_tanh(bflo(w.x))); Y[(c8 + 1) * TS + q] = f2bf(gelu_tanh(bfhi(w.x)));
        Y[(c8 + 2) * TS + q] = f2bf(gelu_tanh(bflo(w.y))); Y[(c8 + 3) * TS + q] = f2bf(gelu_tanh(bfhi(w.y)));
        Y[(c8 + 4) * TS + q] = f2bf(gelu_tanh(bflo(w.z))); Y[(c8 + 5) * TS + q] = f2bf(gelu_tanh(bfhi(w.z)));
        Y[(c8 + 6) * TS + q] = f2bf(gelu_tanh(bflo(w.w))); Y[(c8 + 7) * TS + q] = f2bf(gelu_tanh(bfhi(w.w))); }
    __syncthreads();
    f32x4_t acc[8];
#pragma unroll
    for (int jb = 0; jb < 8; ++jb) acc[jb] = (f32x4_t){0.f, 0.f, 0.f, 0.f};
    tile_mma(acc, X, Y, wid, fr, fq);
    const float* bs = p.in[I_BS] + (l * 4 + g) * 128;
#pragma unroll
    for (int r = 0; r < 4; ++r) { const int pi = 16 * wid + 4 * fq + r; const float bsv = bs[pi];
        const bf16_t* ur = P + (size_t)(row0 + pi) * INC + ZM_OFF + g * 128; bf16_t* orow = H + (size_t)(row0 + pi) * DM + 1024 + g * 128;
#pragma unroll
        for (int jb = 0; jb < 8; ++jb) { const int c = jb * 16 + fr; orow[c] = f2bf(gelu_tanh(bf2f(ur[c])) * (acc[jb][r] + bsv)); } }
    __syncthreads();
}

__device__ __forceinline__ void lru1_item(const Params& p, int l, int ck, int h, int d, LAS unsigned char* lds, int tid, int wid, int lane) {
    const bf16_t* P = (const bf16_t*)(p.ws + WS_PBUF);
    LAS bf16_t* X = (LAS bf16_t*)lds; LAS bf16_t* Y = X + 128 * TS;
    const int fr = lane & 15, fq = lane >> 4;
    int seqbase, L, jc;
    if (ck < 128) { seqbase = (ck >> 4) * SEQ; L = SEQ; jc = ck & 15; } else { const int c2 = ck - 128; seqbase = ML + (c2 >> 1) * CTXL; L = CTXL; jc = c2 & 1; }
    const float* cw = p.in[I_CONVW] + l * 4 * 512 + h * 128; const float* cb = p.in[I_CONVB] + l * 512 + h * 128;
#pragma unroll
    for (int q4 = 0; q4 < 4; ++q4) { const int idx = tid + 512 * q4, t = idx >> 4, c8 = (idx & 15) * 8;
        float xr[8];
        { const f32x4_t b0 = *(const f32x4_t*)(cb + c8), b1 = *(const f32x4_t*)(cb + c8 + 4);
          xr[0] = b0.x; xr[1] = b0.y; xr[2] = b0.z; xr[3] = b0.w; xr[4] = b1.x; xr[5] = b1.y; xr[6] = b1.z; xr[7] = b1.w; }
#pragma unroll
        for (int tap = 0; tap < 4; ++tap) { const int pos = jc * 128 + t + tap - 2;
            if (pos >= 0 && pos < L) {
                const u32x4_t w = *(const u32x4_t*)(P + (size_t)(seqbase + pos) * INC + ZX_OFF + h * 128 + c8);
                const f32x4_t w0 = *(const f32x4_t*)(cw + tap * 512 + c8), w1 = *(const f32x4_t*)(cw + tap * 512 + c8 + 4);
                xr[0] += bflo(w.x) * w0.x; xr[1] += bfhi(w.x) * w0.y; xr[2] += bflo(w.y) * w0.z; xr[3] += bfhi(w.y) * w0.w;
                xr[4] += bflo(w.z) * w1.x; xr[5] += bfhi(w.z) * w1.y; xr[6] += bflo(w.w) * w1.z; xr[7] += bfhi(w.w) * w1.w; } }
        u32x4_t o; o.x = pk2bf(xr[0], xr[1]); o.y = pk2bf(xr[2], xr[3]); o.z = pk2bf(xr[4], xr[5]); o.w = pk2bf(xr[6], xr[7]);
        *(LAS u32x4_t*)(X + t * TS + c8) = o; }
    const bf16_t* LW = (const bf16_t*)(p.ws + WS_LRUW + l * SZ_LRUW);
    stage_tile(Y, LW + (size_t)((d * 2 + 0) * 4 + h) * 16384, 128, tid);
    __syncthreads();
    f32x4_t accR[8], accI[8];
#pragma unroll
    for (int jb = 0; jb < 8; ++jb) { accR[jb] = (f32x4_t){0.f, 0.f, 0.f, 0.f}; accI[jb] = (f32x4_t){0.f, 0.f, 0.f, 0.f}; }
    tile_mma(accR, X, Y, wid, fr, fq);
    __syncthreads();
    stage_tile(Y, LW + (size_t)((d * 2 + 1) * 4 + h) * 16384, 128, tid);
    __syncthreads();
    tile_mma(accI, X, Y, wid, fr, fq);
    float xv[8][4];
#pragma unroll
    for (int jb = 0; jb < 8; ++jb)
#pragma unroll
        for (int r = 0; r < 4; ++r) xv[jb][r] = bf2f(X[(16 * wid + 4 * fq + r) * TS + jb * 16 + fr]);
    __syncthreads();
    LAS float* SA = (LAS float*)lds; LAS float* SB = SA + 16384;
    const float* lb = p.in[I_LRUB] + (size_t)((l * 2 + d) * 2) * 512 + h * 128; const float* lam = p.in[I_LRULAM] + (l * 2 + d) * 512 + h * 128;
#pragma unroll
    for (int jb = 0; jb < 8; ++jb) { const int jj = jb * 16 + fr;
        const float ba = lb[jj], bxb = lb[512 + jj], sp8 = -8.f * log1pf(expf(-lam[jj]));
#pragma unroll
        for (int r = 0; r < 4; ++r) { const int t = 16 * wid + 4 * fq + r;
            const float rg = sigmoid_f(accR[jb][r] + ba), ig = sigmoid_f(accI[jb][r] + bxb);
            const float la = sp8 * rg, av = __expf(la), bv = sqrtf(-expm1f(2.f * la)) * (ig * xv[jb][r]);
            SA[t * 128 + jj] = av; SB[t * 128 + jj] = bv; } }
    __syncthreads();
    if (tid < 128) { float A = 1.f, hs = 0.f;
        if (d == 0) { for (int t = 0; t < 128; ++t) { const float av = SA[t * 128 + tid], bv = SB[t * 128 + tid]; hs = av * hs + bv; A *= av; SA[t * 128 + tid] = A; SB[t * 128 + tid] = hs; } }
        else { for (int t = 127; t >= 0; --t) { const float av = SA[t * 128 + tid], bv = SB[t * 128 + tid]; hs = av * hs + bv; A *= av; SA[t * 128 + tid] = A; SB[t * 128 + tid] = hs; } }
        float* AG = (float*)(p.ws + WS_AGG) + ((size_t)(d * NCHUNK + ck) * 512 + h * 128 + tid) * 2; AG[0] = A; AG[1] = hs; }
    __syncthreads();
    float* AC = (float*)(p.ws + WS_YBUF) + (size_t)(d * 2 + 0) * MT * 512; float* HL = (float*)(p.ws + WS_YBUF) + (size_t)(d * 2 + 1) * MT * 512;
#pragma unroll
    for (int q8 = 0; q8 < 8; ++q8) { const int idx = tid + 512 * q8, t = idx >> 5, c4 = (idx & 31) * 4; const size_t go = (size_t)(ck * 128 + t) * 512 + h * 128 + c4;
        *(f32x4_t*)(AC + go) = *(const LAS f32x4_t*)(SA + t * 128 + c4); *(f32x4_t*)(HL + go) = *(const LAS f32x4_t*)(SB + t * 128 + c4); }
    __syncthreads();
}

__device__ __forceinline__ void lru2_item(const Params& p, int ck, int h, LAS unsigned char* lds, int tid) {
    const bf16_t* P = (const bf16_t*)(p.ws + WS_PBUF); bf16_t* H = (bf16_t*)(p.ws + WS_HBUF);
    LAS float* CR = (LAS float*)lds;
    if (tid < 256) { const int d = tid >> 7, j = tid & 127; const float* AG = (const float*)(p.ws + WS_AGG) + (size_t)d * NCHUNK * 1024 + (h * 128 + j) * 2;
        float c = 0.f;
#define FOLD(q) do { const float* ag = AG + (size_t)(q) * 1024; c = ag[0] * c + ag[1]; } while (0)
        if (ck < 128) { const int b = ck >> 4, jc = ck & 15, cc0 = 128 + 2 * b;
            if (d == 0) { FOLD(cc0); FOLD(cc0 + 1); for (int q = 0; q < jc; ++q) FOLD(b * 16 + q); }
            else { FOLD(cc0 + 1); FOLD(cc0); for (int q = 15; q > jc; --q) FOLD(b * 16 + q); } }
        else { const int c2 = ck - 128, jc = c2 & 1;
            if (d == 0) { if (jc == 1) FOLD(ck - 1); } else { if (jc == 0) FOLD(ck + 1); } }
#undef FOLD
        CR[tid] = c; }
    __syncthreads();
    const float* Yb = (const float*)(p.ws + WS_YBUF); const size_t AS = (size_t)MT * 512;
#pragma unroll
    for (int q8 = 0; q8 < 8; ++q8) { const int idx = tid + 512 * q8, t = idx >> 5, c4 = (idx & 31) * 4; const size_t row = (size_t)ck * 128 + t, go = row * 512 + h * 128 + c4;
        const f32x4_t a0 = *(const f32x4_t*)(Yb + go), h0 = *(const f32x4_t*)(Yb + AS + go), a1 = *(const f32x4_t*)(Yb + 2 * AS + go), h1 = *(const f32x4_t*)(Yb + 3 * AS + go);
        const f32x4_t c0 = *(const LAS f32x4_t*)(CR + c4), c1 = *(const LAS f32x4_t*)(CR + 128 + c4);
        const u32x2_t zg = *(const u32x2_t*)(P + row * INC + ZG_OFF + h * 128 + c4);
        const f32x4_t hs = a0 * c0 + h0 + a1 * c1 + h1;
        u32x2_t o; o.x = pk2bf(hs.x * gelu_tanh(bflo(zg.x)), hs.y * gelu_tanh(bfhi(zg.x))); o.y = pk2bf(hs.z * gelu_tanh(bflo(zg.y)), hs.w * gelu_tanh(bfhi(zg.y)));
        *(u32x2_t*)(H + row * DM + 1536 + h * 128 + c4) = o; }
    __syncthreads();
}

__global__ void __launch_bounds__(512, 2) mega_fwd(Params p) {
    extern __shared__ __attribute__((aligned(16))) unsigned char shm[];
    cg::grid_group grid = cg::this_grid();
    LAS unsigned char* lds = (LAS unsigned char*)shm;
#define OPAQUE_TID() int tid_o = threadIdx.x; asm volatile("" : "+v"(tid_o)); const int tid = tid_o, wid = __builtin_amdgcn_readfirstlane(tid >> 6), lane = tid & 63, gw = blockIdx.x * 8 + wid; (void)gw; (void)lane; (void)tid
    const int G = gridDim.x, NGW = G * 8;
    unsigned char* ws = p.ws;
    const float* MOD = (const float*)(ws + WS_MOD);
    bf16_t* HB = (bf16_t*)(ws + WS_HBUF); bf16_t* PB = (bf16_t*)(ws + WS_PBUF); float* YB = (float*)(ws + WS_YBUF); float* XC = (float*)(ws + WS_XC);

#ifndef NO_P0
    { OPAQUE_TID(); phase0(p, lds, tid, wid, lane); }
#endif
    grid.sync();
#ifndef NO_ROWS
    { OPAQUE_TID(); phaseA(p, gw, NGW, lane); }
#endif
    grid.sync();

#pragma unroll 1
    for (int l = 0; l < NLAYER; ++l) {
        const bool last = (l == NLAYER - 1);
        const int mrows = last ? ML : MT;
#ifndef NO_G1
        { pg8::StaticOrder S; S.init(MT, INC, G, blockIdx.x); pg8::EpiBf16 E{PB, INC};
          pg8::gemm_phase<pg8::EpiBf16, pg8::StaticOrder, false>(lds, pg8::Gemm{HB, (const bf16_t*)(ws + WS_WIN + l * SZ_WIN), MT, INC, DM}, S, E, nullptr); }
#endif
        grid.sync();
#ifndef NO_C
        { OPAQUE_TID(); const int n_lru = NCHUNK * 8, n_mlp = (last ? 128 : NCHUNK) * 4;
          for (int it = blockIdx.x; it < n_lru + n_mlp; it += G) {
              if (it < n_lru) lru1_item(p, l, it >> 3, (it >> 1) & 3, it & 1, lds, tid, wid, lane);
              else { const int r = it - n_lru; mlp_item(p, l, r >> 2, r & 3, lds, tid, wid, lane); } }
          qk_rows(p, l, gw, NGW, lane); }
#endif
        grid.sync();
#ifndef NO_D
        { OPAQUE_TID(); const int n_att = 512 + (last ? 0 : 64), n_l2 = (last ? 128 : NCHUNK) * 4;
          for (int it = blockIdx.x; it < n_att + n_l2; it += G) {
              if (it < n_att) {
                  size_t qrow, orow; int b, hq, seq;
                  if (it < 512) { b = it >> 6; hq = (it >> 3) & 7; const int qb = it & 7; qrow = (size_t)b * SEQ + qb * 256; seq = SKV; }
                  else { const int c = it - 512; b = c >> 3; hq = c & 7; qrow = (size_t)ML + b * CTXL; seq = CTXL; }
                  orow = qrow;
                  const size_t kvo = (size_t)(b * 2 + (hq >> 2)) * SKV * 128;
                  attn_dense_body<bf16>((const bf16*)(PB + qrow * INC + hq * 128), (const bf16*)((const bf16_t*)(ws + WS_KBUF) + kvo), (const bf16*)((const bf16_t*)(ws + WS_VBUF) + kvo),
                                        HB + orow * DM + hq * 128, seq, (char*)shm);
                  __syncthreads();
              } else {
#ifndef NO_L2
                  const int r = it - n_att; lru2_item(p, r >> 2, r & 3, lds, tid);
#endif
              } } }
#endif
        grid.sync();
#ifndef NO_G2
        { pg8::StaticOrder S; S.init(mrows, DM, G, blockIdx.x); pg8::EpiF32 E{YB, DM};
          pg8::gemm_phase<pg8::EpiF32, pg8::StaticOrder, false>(lds, pg8::Gemm{HB, (const bf16_t*)(ws + WS_WOUT + l * SZ_WOUT), mrows, DM, DM}, S, E, nullptr); }
#endif
        grid.sync();
#ifndef NO_ROWS
        { OPAQUE_TID(); const float* gn = p.in[I_GNORM] + (size_t)l * 4 * DM; const float* ml = MOD + (size_t)l * 9 * 6 * DM;
          row_update(p, mrows, l == 0 ? p.in[I_X] : p.out, l == 0 ? p.in[I_CTX] : XC, p.out, XC, ml, 2 * DM, gn + DM, true, gn + 2 * DM, ml, 3 * DM, 4 * DM, gw, NGW, lane); }
#endif
        grid.sync();
#ifndef NO_G3
        { pg8::StaticOrder S; S.init(mrows, 2 * DFF, G, blockIdx.x); pg8::EpiSwiglu E{PB, DFF};
          pg8::gemm_phase<pg8::EpiSwiglu, pg8::StaticOrder, false>(lds, pg8::Gemm{HB, (const bf16_t*)(ws + WS_WFI + l * SZ_WFI), mrows, 2 * DFF, DM}, S, E, nullptr); }
#endif
        grid.sync();
#ifndef NO_G4
        { pg8::StaticOrder S; S.init(mrows, DM, G, blockIdx.x); pg8::EpiF32 E{YB, DM};
          pg8::gemm_phase<pg8::EpiF32, pg8::StaticOrder, false>(lds, pg8::Gemm{PB, (const bf16_t*)(ws + WS_WFO + l * SZ_WFO), mrows, DM, DFF}, S, E, nullptr); }
#endif
        grid.sync();
#ifndef NO_ROWS
        { OPAQUE_TID(); const float* gn = p.in[I_GNORM] + (size_t)l * 4 * DM; const float* ml = MOD + (size_t)l * 9 * 6 * DM;
          const float* gnn = p.in[I_GNORM] + (size_t)(last ? l : l + 1) * 4 * DM; const float* mln = MOD + (size_t)(last ? l : l + 1) * 9 * 6 * DM;
          row_update(p, mrows, p.out, XC, p.out, XC, ml, 5 * DM, gn + 3 * DM, !last, gnn, mln, 0, DM, gw, NGW, lane); }
#endif
        if (!last) grid.sync();
    }
}

extern "C" void kernel_launch(void* const* d_in, const int* in_sizes, int n_in, void* d_out, int out_size, void* d_ws, size_t ws_size, hipStream_t stream) {
    static int grid_blocks = 0;
    if (grid_blocks == 0) {
        if (n_in != 19 || out_size != ML * DM || ws_size < WS_END) { fprintf(stderr, "kernel_launch: unexpected shapes (n_in %d out %d ws %zu need %zu)\n", n_in, out_size, ws_size, (size_t)WS_END); grid_blocks = -1; return; }
        int dev = 0, cus = 0, per_cu = 0;
        hipGetDevice(&dev);
        hipDeviceGetAttribute(&cus, hipDeviceAttributeMultiprocessorCount, dev);
        if (hipFuncSetAttribute((const void*)mega_fwd, hipFuncAttributeMaxDynamicSharedMemorySize, LDS_BYTES) != hipSuccess) { fprintf(stderr, "kernel_launch: hipFuncSetAttribute failed\n"); grid_blocks = -1; return; }
        if (hipOccupancyMaxActiveBlocksPerMultiprocessor(&per_cu, (const void*)mega_fwd, 512, LDS_BYTES) != hipSuccess || per_cu < 1) { fprintf(stderr, "kernel_launch: occupancy query failed (%d)\n", per_cu); per_cu = 1; }
        (void)hipGetLastError();
        grid_blocks = cus * 1;
    }
    if (grid_blocks < 0) return;
    Params p{};
    for (int i = 0; i < 19; ++i) p.in[i] = (const float*)d_in[i];
    p.out = (float*)d_out; p.ws = (unsigned char*)d_ws;
    void* args[] = {&p};
    hipError_t e = hipLaunchCooperativeKernel((const void*)mega_fwd, dim3(grid_blocks), dim3(512), args, LDS_BYTES, stream);
    if (e != hipSuccess) fprintf(stderr, "cooperative launch failed: %s (grid %d)\n", hipGetErrorString(e), grid_blocks);
}
```

```cpp
#define ATT_QFUSE 1
#include <hip/hip_runtime.h>
#include <hip/hip_bf16.h>
#include <hip/hip_cooperative_groups.h>
#include <cstdio>
#include <cstdint>
namespace cg = cooperative_groups;

#define LAS __attribute__((address_space(3)))
typedef unsigned short bf16_t;
typedef float f32x4_t __attribute__((ext_vector_type(4)));
typedef float f32x2_t __attribute__((ext_vector_type(2)));
typedef unsigned u32x4_t __attribute__((ext_vector_type(4)));
typedef unsigned u32x2_t __attribute__((ext_vector_type(2)));

constexpr int DM = 2048, NB = 8, SEQ = 2048, CTXL = 256, NLAYER = 2;
constexpr int ML = NB * SEQ, MC = NB * CTXL, MT = ML + MC;
constexpr int INC = 3584, DFF = 5632, SKV = CTXL + SEQ;
constexpr int K_OFF = 1024, V_OFF = 1280, ZM_OFF = 1536, ZX_OFF = 2560, ZG_OFF = 3072;
constexpr int NCHUNK = MT / 128;
constexpr float EPS = 1e-6f;

constexpr size_t SZ_WIN = (size_t)INC * DM * 2, SZ_WOUT = (size_t)DM * DM * 2, SZ_WFI = (size_t)2 * DFF * DM * 2, SZ_WFO = (size_t)DM * DFF * 2;
constexpr size_t SZ_LRUW = (size_t)16 * 128 * 128 * 2, SZ_WSB = (size_t)4 * 128 * 128 * 2, SZ_MOD = (size_t)NLAYER * 9 * 6 * DM * 4;
constexpr size_t WS_WIN = 0;
constexpr size_t WS_WOUT = WS_WIN + NLAYER * SZ_WIN;
constexpr size_t WS_WFI = WS_WOUT + NLAYER * SZ_WOUT;
constexpr size_t WS_WFO = WS_WFI + NLAYER * SZ_WFI;
constexpr size_t WS_LRUW = WS_WFO + NLAYER * SZ_WFO;
constexpr size_t WS_WSB = WS_LRUW + NLAYER * SZ_LRUW;
constexpr size_t WS_MOD = WS_WSB + NLAYER * SZ_WSB;
constexpr size_t WS_HBUF = WS_MOD + SZ_MOD;
constexpr size_t WS_PBUF = WS_HBUF + (size_t)MT * DM * 2;
constexpr size_t WS_YBUF = WS_PBUF + (size_t)MT * DFF * 2;
constexpr size_t WS_YPART = WS_YBUF + (size_t)MT * DM * 2;
constexpr size_t WS_KBUF = WS_YBUF + (size_t)MT * DM * 4;
constexpr size_t WS_VBUF = WS_KBUF + (size_t)NB * 2 * SKV * 128 * 2;
constexpr size_t WS_XC = WS_VBUF + (size_t)NB * 2 * SKV * 128 * 2;
constexpr size_t WS_AGG = WS_XC + (size_t)MC * DM * 4;
constexpr size_t WS_BAR = WS_AGG + (size_t)2 * NCHUNK * 512 * 2 * 4;
constexpr size_t WS_XB = WS_BAR + 16384;
constexpr size_t WS_END = WS_XB + (size_t)MT * DM * 2;
constexpr int LDS_BYTES = 131072 + 64 + 8192;

__device__ __forceinline__ unsigned pk2bf(float lo, float hi) { unsigned r; asm volatile("v_cvt_pk_bf16_f32 %0, %1, %2" : "=v"(r) : "v"(lo), "v"(hi)); return r; }
__device__ __forceinline__ unsigned short f2bf(float f) { return (unsigned short)(pk2bf(f, 0.f) & 0xffffu); }
__device__ __forceinline__ float bf2f(unsigned short b) { return __uint_as_float(((unsigned)b) << 16); }
__device__ __forceinline__ float bflo(unsigned w) { return __uint_as_float(w << 16); }
__device__ __forceinline__ float bfhi(unsigned w) { return __uint_as_float(w & 0xffff0000u); }
__device__ __forceinline__ float sigmoid_f(float x) { return __builtin_amdgcn_rcpf(1.f + __expf(-x)); }
__device__ __forceinline__ float gelu_tanh(float x) { const float u = 1.5957691216057308f * (x + 0.044715f * x * x * x); return x * sigmoid_f(u); }
__device__ __forceinline__ float wave_sum(float v) {
#pragma unroll
    for (int o = 1; o < 64; o <<= 1) v += __shfl_xor(v, o);
    return v;
}
#define LDS_WAIT() asm volatile("s_waitcnt lgkmcnt(0)" ::: "memory")

namespace pg8 {
#define PG8_LAS __attribute__((address_space(3)))
typedef unsigned short bf16_t;
typedef short bf16x8 __attribute__((ext_vector_type(8)));
typedef float f32x4 __attribute__((ext_vector_type(4)));
typedef unsigned u32x4 __attribute__((ext_vector_type(4)));
constexpr int BM = 256, BK = 64, HALF = 128, HTB = HALF * BK * 2  , STAGE_BYTES = 8 * HTB, NXCD = 8, WGM = 8;

__host__ __device__ __forceinline__ int lds_byte(int r, int c) { const int st = (r >> 4) * 2 + (c >> 5), rr = r & 15, cc = c & 31, ob = rr * 64 + cc * 2; return st * 1024 + (ob ^ (((ob >> 9) & 1) << 5)); }
__host__ __device__ __forceinline__ void stage_rc(int b, int& R, int& C) { const int st = b / 1024, sb = b % 1024, swz = sb ^ (((sb >> 9) & 1) << 5); R = (st >> 1) * 16 + swz / 64; C = (st & 1) * 32 + (swz % 64) / 2; }
__host__ __device__ __forceinline__ int perm32(int rho) { const int n = rho >> 4, i = rho & 15; return 8 * (i >> 2) + 4 * n + (i & 3); }

struct Unit { int pm, pn, ks; };
struct Gemm { const bf16_t* A; const bf16_t* Bt; int M, N, K, ld; };

struct StaticOrder {
    int nM, nN, nwg, G, c;
    __host__ __device__ void init(int M, int N, int G_, int c_) { nM = M / BM; nN = N / BM; nwg = nM * nN; G = G_; c = c_; }
    __host__ __device__ bool next(int i, Unit& u) const {
        const long L = (long)i * G + c; if (L >= nwg) return false;
        int wgid = (int)L; { const int q = nwg / NXCD, r = nwg % NXCD, xcd = wgid % NXCD, off = wgid / NXCD; wgid = (xcd < r ? xcd * (q + 1) : r * (q + 1) + (xcd - r) * q) + off; }
        const int nig = WGM * nN, gid = wgid / nig, fm = gid * WGM, gsz = (nM - fm) < WGM ? (nM - fm) : WGM;
        u.pm = fm + ((wgid % nig) % gsz); u.pn = (wgid % nig) / gsz; u.ks = 0; return true;
    }
    __device__ __forceinline__ void a_ready(const Unit&) const {}
    __device__ __forceinline__ void done(const Unit&) const {}
};
struct SplitOrder {
    int nM, nN, NS, G, c;
    __host__ __device__ void init(int M, int N, int NS_, int G_, int c_) { nM = M / BM; nN = N / BM; NS = NS_; G = G_; c = c_; }
    __host__ __device__ bool next(int i, Unit& u) const {
        const long L = (long)i * G + c; if (L >= (long)nM * nN * NS) return false;
        const int ks = (int)(L % NS), tile = (int)(L / NS); u.pm = tile % nM; u.pn = tile / nM; u.ks = ks; return true;
    }
    __device__ __forceinline__ void a_ready(const Unit&) const {}
    __device__ __forceinline__ void done(const Unit&) const {}
};
__device__ __forceinline__ unsigned cvt_pk_bf16(float lo, float hi) { unsigned r; asm volatile("v_cvt_pk_bf16_f32 %0, %1, %2" : "=v"(r) : "v"(lo), "v"(hi)); return r; }
struct EpiF32 {
    static constexpr bool PERM = false, AFTER_DRAIN = false;
    float* C; int ldc;
    __device__ __forceinline__ void operator()(const f32x4 (&acc)[2][2][4][2], const Unit& u, int wr, int wc, int fr, int fq) const {
        const int row0 = u.pm * BM + wr * 64 + fr, col0 = u.pn * BM + wc * 32 + 4 * fq;
#pragma unroll
        for (int ai = 0; ai < 2; ++ai)
#pragma unroll
            for (int m = 0; m < 4; ++m) { float* rowp = C + (size_t)(row0 + ai * HALF + m * 16) * ldc + col0;
#pragma unroll
                for (int bj = 0; bj < 2; ++bj)
#pragma unroll
                    for (int n = 0; n < 2; ++n) *(f32x4*)(rowp + bj * HALF + n * 16) = acc[ai][bj][m][n]; }
    }
};
struct EpiBf16 {
    static constexpr bool PERM = true, AFTER_DRAIN = false;
    bf16_t* O; int ldc;
    __device__ __forceinline__ void operator()(const f32x4 (&acc)[2][2][4][2], const Unit& u, int wr, int wc, int fr, int fq) const {
        const int row0 = u.pm * BM + wr * 64 + fr, col0 = u.pn * BM + wc * 32 + 8 * fq;
#pragma unroll
        for (int ai = 0; ai < 2; ++ai)
#pragma unroll
            for (int m = 0; m < 4; ++m) { bf16_t* rowp = O + (size_t)(row0 + ai * HALF + m * 16) * ldc + col0;
#pragma unroll
                for (int bj = 0; bj < 2; ++bj) { const f32x4 v0 = acc[ai][bj][m][0], v1 = acc[ai][bj][m][1];
                    u32x4 w; w.x = cvt_pk_bf16(v0[0], v0[1]); w.y = cvt_pk_bf16(v0[2], v0[3]); w.z = cvt_pk_bf16(v1[0], v1[1]); w.w = cvt_pk_bf16(v1[2], v1[3]);
                    *(u32x4*)(rowp + bj * HALF) = w; } }
    }
};
struct EpiSwiglu {
    static constexpr bool PERM = true, AFTER_DRAIN = false;
    bf16_t* O; int ldc;
    __device__ __forceinline__ void operator()(const f32x4 (&acc)[2][2][4][2], const Unit& u, int wr, int wc, int fr, int fq) const {
        const int row0 = u.pm * BM + wr * 64 + fr, col0 = u.pn * HALF + wc * 32 + 8 * fq;
#pragma unroll
        for (int ai = 0; ai < 2; ++ai)
#pragma unroll
            for (int m = 0; m < 4; ++m) { bf16_t* rowp = O + (size_t)(row0 + ai * HALF + m * 16) * ldc + col0;
                float v[8];
#pragma unroll
                for (int n = 0; n < 2; ++n)
#pragma unroll
                    for (int j = 0; j < 4; ++j) { const float g = acc[ai][0][m][n][j], uu = acc[ai][1][m][n][j];
                        v[n * 4 + j] = g * __builtin_amdgcn_rcpf(1.f + __expf(-g)) * uu; }
                u32x4 w; w.x = cvt_pk_bf16(v[0], v[1]); w.y = cvt_pk_bf16(v[2], v[3]); w.z = cvt_pk_bf16(v[4], v[5]); w.w = cvt_pk_bf16(v[6], v[7]);
                *(u32x4*)rowp = w; }
    }
};
struct EpiF32Split {
    static constexpr bool PERM = false, AFTER_DRAIN = false;
    float* C; int ldc; size_t split_stride;
    __device__ __forceinline__ void operator()(const f32x4 (&acc)[2][2][4][2], const Unit& u, int wr, int wc, int fr, int fq) const {
        const int row0 = u.pm * BM + wr * 64 + fr, col0 = u.pn * BM + wc * 32 + 4 * fq; float* Cb = C + (size_t)u.ks * split_stride;
#pragma unroll
        for (int ai = 0; ai < 2; ++ai)
#pragma unroll
            for (int m = 0; m < 4; ++m) { float* rowp = Cb + (size_t)(row0 + ai * HALF + m * 16) * ldc + col0;
#pragma unroll
                for (int bj = 0; bj < 2; ++bj)
#pragma unroll
                    for (int n = 0; n < 2; ++n) *(f32x4*)(rowp + bj * HALF + n * 16) = acc[ai][bj][m][n]; }
    }
};
struct EpiBf16Split {
    static constexpr bool PERM = true, AFTER_DRAIN = false;
    bf16_t* O; int ldc; size_t split_stride;
    __device__ __forceinline__ void operator()(const f32x4 (&acc)[2][2][4][2], const Unit& u, int wr, int wc, int fr, int fq) const {
        const int row0 = u.pm * BM + wr * 64 + fr, col0 = u.pn * BM + wc * 32 + 8 * fq; bf16_t* Ob = O + (size_t)u.ks * split_stride;
#pragma unroll
        for (int ai = 0; ai < 2; ++ai)
#pragma unroll
            for (int m = 0; m < 4; ++m) { bf16_t* rowp = Ob + (size_t)(row0 + ai * HALF + m * 16) * ldc + col0;
#pragma unroll
                for (int bj = 0; bj < 2; ++bj) { const f32x4 v0 = acc[ai][bj][m][0], v1 = acc[ai][bj][m][1];
                    u32x4 w; w.x = cvt_pk_bf16(v0[0], v0[1]); w.y = cvt_pk_bf16(v0[2], v0[3]); w.z = cvt_pk_bf16(v1[0], v1[1]); w.w = cvt_pk_bf16(v1[2], v1[3]);
                    *(u32x4*)(rowp + bj * HALF) = w; } }
    }
};
template <class Epi, class Sched, bool STAMP = false>
__device__ __forceinline__ void gemm_phase(PG8_LAS unsigned char* lds, const Gemm g, const Sched& S, const Epi& E, unsigned long long* stamps) {
    int tid_o = threadIdx.x; asm volatile("" : "+v"(tid_o));
    const int tid = tid_o, wid = __builtin_amdgcn_readfirstlane(tid >> 6), lane = tid & 63, wr = wid >> 2, wc = wid & 3, fr = lane & 15, fq = lane >> 4;
    const int K = g.K, nt = K / BK, LD = g.ld;
    int ts_lo = 0, ts_hi = 0, nts = 0; const unsigned long long rt_entry = STAMP ? (unsigned long long)wall_clock64() : 0ull;
#define PG8_STAMP() do { if (STAMP && wid == 0 && nts < 64) { const unsigned long long _c = (unsigned long long)clock64(); \
        ts_lo = (lane == nts) ? (int)(unsigned)_c : ts_lo; ts_hi = (lane == nts) ? (int)(unsigned)(_c >> 32) : ts_hi; ++nts; } } while (0)
    PG8_STAMP();
    unsigned voffA[2], voffB[2];
#pragma unroll
    for (int i = 0; i < 2; ++i) { int R, C; stage_rc(tid * 16 + i * 8192, R, C); const int Rb = Epi::PERM ? ((R & ~31) + perm32(R & 31)) : R;
        voffA[i] = (unsigned)(R * LD + C) * 2u; voffB[i] = (unsigned)(Rb * LD + C) * 2u; }
    const size_t kstep = (size_t)(BK * 2);
    const size_t hstep = (size_t)HALF * LD * 2;
    const size_t tstep = 2 * hstep;
    const unsigned ldsw = (unsigned)wid * 1024u;
    const int aoff = lds_byte(wr * 64 + fr, fq * 8), boff = lds_byte(wc * 32 + fr, fq * 8);
#define PG8_SA(b, h) (((b) * 2 + (h)) * HTB)
#define PG8_SB(b, h) ((4 + (b) * 2 + (h)) * HTB)
#define PG8_STAGE(bufoff, gbase, voff) do { _Pragma("unroll") for (int _i = 0; _i < 2; ++_i) \
        __builtin_amdgcn_global_load_lds((const unsigned*)((const char*)(gbase) + (voff)[_i]), (PG8_LAS unsigned*)(lds + (bufoff) + ldsw + _i * 8192), 16, 0, 0); } while (0)
#define PG8_LDA(dst, b, h) do { _Pragma("unroll") for (int m = 0; m < 4; ++m) _Pragma("unroll") for (int k = 0; k < 2; ++k) dst[m][k] = *(const PG8_LAS bf16x8*)(lds + PG8_SA(b, h) + aoff + m * 2048 + k * 1024); } while (0)
#define PG8_LDB(dst, b, h) do { _Pragma("unroll") for (int n = 0; n < 2; ++n) _Pragma("unroll") for (int k = 0; k < 2; ++k) dst[n][k] = *(const PG8_LAS bf16x8*)(lds + PG8_SB(b, h) + boff + n * 2048 + k * 1024); } while (0)
#define PG8_MMA(ai, bj, At, Bt) do { __builtin_amdgcn_s_setprio(1); _Pragma("unroll") for (int m = 0; m < 4; ++m) _Pragma("unroll") for (int n = 0; n < 2; ++n) _Pragma("unroll") for (int k = 0; k < 2; ++k) \
        acc[ai][bj][m][n] = __builtin_amdgcn_mfma_f32_16x16x32_bf16(Bt[n][k], At[m][k], acc[ai][bj][m][n], 0, 0, 0); __builtin_amdgcn_s_setprio(0); } while (0)
#define PG8_WAIT_V(n) asm volatile("s_waitcnt vmcnt(" #n ")" ::: "memory")
#define PG8_WAIT_L(n) asm volatile("s_waitcnt lgkmcnt(" #n ")" ::: "memory")
#define PG8_BAR __builtin_amdgcn_s_barrier()
#define PG8_SCHED __builtin_amdgcn_sched_barrier(0)
    Unit cur, nxt; int ui = 0;
    if (!S.next(0, cur)) return;
    f32x4 acc[2][2][4][2];
#pragma unroll
    for (int a = 0; a < 2; ++a)
#pragma unroll
        for (int b = 0; b < 2; ++b)
#pragma unroll
            for (int m = 0; m < 4; ++m)
#pragma unroll
                for (int n = 0; n < 2; ++n) acc[a][b][m][n] = (f32x4){0.f, 0.f, 0.f, 0.f};
    bf16x8 At[4][2], B0[2][2], B1[2][2];
    const size_t ksb = (size_t)K * 2;
    const char* cA = (const char*)g.A + (size_t)cur.pm * tstep + (size_t)cur.ks * ksb; const char* cB = (const char*)g.Bt + (size_t)cur.pn * tstep + (size_t)cur.ks * ksb;
    S.a_ready(cur);
    PG8_STAGE(PG8_SB(0, 0), cB, voffB); PG8_STAGE(PG8_SA(0, 0), cA, voffA); PG8_STAGE(PG8_SB(0, 1), cB + hstep, voffB); PG8_STAGE(PG8_SA(0, 1), cA + hstep, voffA);
    if (wr == 1) PG8_BAR;
    PG8_WAIT_V(4); PG8_BAR;
    PG8_STAGE(PG8_SB(1, 0), cB + kstep, voffB); PG8_STAGE(PG8_SA(1, 0), cA + kstep, voffA); PG8_STAGE(PG8_SB(1, 1), cB + hstep + kstep, voffB);
    PG8_WAIT_V(6); PG8_BAR;
    PG8_STAMP();
    for (;;) {
        const bool has_next = S.next(ui + 1, nxt);
        const char* nA = has_next ? (const char*)g.A + (size_t)nxt.pm * tstep + (size_t)nxt.ks * ksb : cA; const char* nB = has_next ? (const char*)g.Bt + (size_t)nxt.pn * tstep + (size_t)nxt.ks * ksb : cB;
        for (int t = 0; t < nt; t += 2) {
            const bool last = (t == nt - 2);
            const char* a1 = cA + (size_t)(t + 1) * kstep;
            const char* a2 = last ? nA : cA + (size_t)(t + 2) * kstep; const char* b2 = last ? nB : cB + (size_t)(t + 2) * kstep;
            const char* a3 = a2 + kstep; const char* b3 = b2 + kstep;
            if (last && has_next) S.a_ready(nxt);
            PG8_LDB(B0, 0, 0); PG8_SCHED; PG8_LDA(At, 0, 0); PG8_STAGE(PG8_SA(1, 1), a1 + hstep, voffA);
            PG8_WAIT_L(8); PG8_BAR; PG8_WAIT_L(0); PG8_MMA(0, 0, At, B0); PG8_BAR; PG8_SCHED;
            PG8_LDB(B1, 0, 1); PG8_STAGE(PG8_SB(0, 0), b2, voffB);
            PG8_BAR; PG8_WAIT_L(0); PG8_MMA(0, 1, At, B1); PG8_BAR;
            PG8_LDA(At, 0, 1); PG8_STAGE(PG8_SA(0, 0), a2, voffA);
            PG8_BAR; PG8_WAIT_L(0); PG8_MMA(1, 0, At, B0); PG8_BAR; PG8_SCHED;
            PG8_STAGE(PG8_SB(0, 1), b2 + hstep, voffB);
            PG8_WAIT_V(6); PG8_BAR; PG8_MMA(1, 1, At, B1); PG8_BAR;
            PG8_LDB(B0, 1, 0); PG8_SCHED; PG8_LDA(At, 1, 0); PG8_STAGE(PG8_SA(0, 1), a2 + hstep, voffA);
            PG8_WAIT_L(8); PG8_BAR; PG8_WAIT_L(0); PG8_MMA(0, 0, At, B0); PG8_BAR; PG8_SCHED;
            PG8_LDB(B1, 1, 1); PG8_STAGE(PG8_SB(1, 0), b3, voffB);
            PG8_BAR; PG8_WAIT_L(0); PG8_MMA(0, 1, At, B1); PG8_BAR;
            PG8_LDA(At, 1, 1); PG8_STAGE(PG8_SA(1, 0), a3, voffA);
            PG8_BAR; PG8_WAIT_L(0); PG8_MMA(1, 0, At, B0); PG8_BAR; PG8_SCHED;
            PG8_STAGE(PG8_SB(1, 1), b3 + hstep, voffB);
            PG8_WAIT_V(6); PG8_BAR; PG8_MMA(1, 1, At, B1); PG8_BAR;
        }
        PG8_STAMP();
        if constexpr (!Epi::AFTER_DRAIN) { E(acc, cur, wr, wc, fr, fq); S.done(cur); }
        PG8_STAMP();
        if (!has_next) break;
#pragma unroll
        for (int a = 0; a < 2; ++a)
#pragma unroll
            for (int b = 0; b < 2; ++b)
#pragma unroll
                for (int m = 0; m < 4; ++m)
#pragma unroll
                    for (int n = 0; n < 2; ++n) acc[a][b][m][n] = (f32x4){0.f, 0.f, 0.f, 0.f};
        cur = nxt; cA = nA; cB = nB; ++ui;
    }
    PG8_WAIT_V(0);
    if (wr == 0) PG8_BAR;
    PG8_BAR;
    if constexpr (Epi::AFTER_DRAIN) { E.fused(acc, cur, wr, wc, fr, fq, lds, wid, lane); S.done(cur); }
    PG8_STAMP();
    if (STAMP && wid == 0) { stamps[lane] = lane < nts ? (((unsigned long long)(unsigned)ts_hi << 32) | (unsigned)ts_lo) : 0ull;
        if (lane == 62) stamps[62] = rt_entry; if (lane == 63) stamps[63] = (unsigned long long)wall_clock64(); }
#undef PG8_STAMP
#undef PG8_SA
#undef PG8_SB
#undef PG8_STAGE
#undef PG8_LDA
#undef PG8_LDB
#undef PG8_MMA
#undef PG8_WAIT_V
#undef PG8_WAIT_L
#undef PG8_BAR
#undef PG8_SCHED
}
}

using bf16 = __hip_bfloat16;
constexpr int   D = 128, NW = 8, QBLK = 32, KVBLK = 64;
constexpr float SCALE = 0.088388347648318440f;
constexpr float THR = 8.f;
#ifndef ATT_SDEPTH
#define ATT_SDEPTH 1
#endif
constexpr int SDEPTH = ATT_SDEPTH;
constexpr int LDQ = INC, LDK = 128, LDO = DM;
constexpr size_t SHM_V = KVBLK * D * 2, SHM_K = KVBLK * D * 2, SHM_ATTN = 2 * SHM_V + 2 * SHM_K + NW * 64 * 4;
using bf16x8 = __attribute__((ext_vector_type(8))) short;
using s16x4  = __attribute__((ext_vector_type(4))) short;
using f32x16 = __attribute__((ext_vector_type(16))) float;
using f32x8  = __attribute__((ext_vector_type(8))) float;
using u32x4  = __attribute__((ext_vector_type(4))) unsigned;
#define KSWZ(row, colB) ((row) * 256 + ((colB) ^ (((row) & 7) << 4)))
#define SBAR() __builtin_amdgcn_sched_barrier(0)
__device__ __forceinline__ int crow(int r, int hi) { return (r & 3) + 8 * (r >> 2) + 4 * hi; }
__device__ __forceinline__ unsigned cvtpk(float lo, float hi) {
  unsigned r; asm volatile("v_cvt_pk_bf16_f32 %0, %1, %2" : "=v"(r) : "v"(lo), "v"(hi)); return r;
}
template <typename TIn> struct Stage;
template <> struct Stage<bf16>  { using T = bf16x8;
  __device__ static __forceinline__ T ld8(const bf16* p) { return *reinterpret_cast<const bf16x8*>(p); }
  __device__ static __forceinline__ bf16x8 tobf(T x) { return x; } };
template <> struct Stage<float> { using T = f32x8;
  __device__ static __forceinline__ T ld8(const float* p) { return *reinterpret_cast<const f32x8*>(p); }
  __device__ static __forceinline__ bf16x8 tobf(T x) {
    u32x4 w = {cvtpk(x[0], x[1]), cvtpk(x[2], x[3]), cvtpk(x[4], x[5]), cvtpk(x[6], x[7])}; return *reinterpret_cast<bf16x8*>(&w); } };

__device__ __forceinline__ void partialSM(f32x16& p0, f32x16& p1, float& m_reg, float& mn, float& alpha) {
  constexpr float C = SCALE * 1.4426950408889634f;
  float pmax = p0[0]; for (int r = 1; r < 16; ++r) pmax = fmaxf(pmax, p0[r]); for (int r = 0; r < 16; ++r) pmax = fmaxf(pmax, p1[r]);
  { auto rr = __builtin_amdgcn_permlane32_swap(__float_as_uint(pmax), __float_as_uint(pmax), false, false);
    pmax = fmaxf(__uint_as_float(rr[0]), __uint_as_float(rr[1])); }
  if (__builtin_expect(__all(pmax - m_reg <= THR / SCALE), 1)) { mn = m_reg; alpha = 1.f; }
  else { mn = fmaxf(m_reg, pmax); alpha = __builtin_amdgcn_exp2f((m_reg - mn) * C); m_reg = mn; }
  float mnC = -mn * C;
  for (int r = 0; r < 16; ++r) p0[r] = fmaf(p0[r], C, mnC); for (int r = 0; r < 16; ++r) p1[r] = fmaf(p1[r], C, mnC);
  for (int r = 0; r < 16; ++r) p0[r] = __builtin_amdgcn_exp2f(p0[r]);
}
__device__ __forceinline__ void finishSM(f32x16& p0, f32x16& p1, float alpha, float& l_reg, bf16x8& pa0, bf16x8& pa1, bf16x8& pa2, bf16x8& pa3) {
  for (int r = 0; r < 16; ++r) p1[r] = __builtin_amdgcn_exp2f(p1[r]);
  float ps = 0; for (int r = 0; r < 16; ++r) ps += p0[r]; for (int r = 0; r < 16; ++r) ps += p1[r];
  { auto rr = __builtin_amdgcn_permlane32_swap(__float_as_uint(ps), __float_as_uint(ps), false, false);
    ps = __uint_as_float(rr[0]) + __uint_as_float(rr[1]); }
  l_reg = l_reg * alpha + ps;
#define PK4(P, BASE, OUT) do { unsigned a0 = cvtpk(P[BASE + 0], P[BASE + 1]), a1 = cvtpk(P[BASE + 2], P[BASE + 3]);   \
    unsigned b0 = cvtpk(P[BASE + 4], P[BASE + 5]), b1 = cvtpk(P[BASE + 6], P[BASE + 7]);                              \
    auto r0 = __builtin_amdgcn_permlane32_swap(a0, b0, false, false); auto r1 = __builtin_amdgcn_permlane32_swap(a1, b1, false, false); \
    u32x4 w = {r0[0], r1[0], r0[1], r1[1]}; OUT = *reinterpret_cast<bf16x8*>(&w); } while (0)
  PK4(p0, 0, pa0); PK4(p0, 8, pa1); PK4(p1, 0, pa2); PK4(p1, 8, pa3);
#undef PK4
}
__device__ __forceinline__ void qkt(f32x16& p0, f32x16& p1, const bf16* Ks, const bf16x8* qr, int r32, int hi) {
  p0 = f32x16{}; p1 = f32x16{};
  for (int d0 = 0; d0 < 8; ++d0) { int cb = (d0 * 16 + hi * 8) * 2;
    bf16x8 b0 = *reinterpret_cast<const bf16x8*>((const char*)Ks + KSWZ(r32, cb));
    bf16x8 b1 = *reinterpret_cast<const bf16x8*>((const char*)Ks + KSWZ(32 + r32, cb));
    p0 = __builtin_amdgcn_mfma_f32_32x32x16_bf16(b0, qr[d0], p0, 0, 0, 0);
    p1 = __builtin_amdgcn_mfma_f32_32x32x16_bf16(b1, qr[d0], p1, 0, 0, 0); }
}
__device__ __forceinline__ int v_st(int k, int c) { const int kk = (k & ~0xC) | ((k & 4) << 1) | ((k & 8) >> 1); return ((kk >> 3) * 4 + (c >> 5)) * 512 + ((kk & 7) * 32 + (c & 31)) * 2; }
__device__ __forceinline__ int v_rd_base(int lane) { return ((lane & 3) << 3) | (((lane >> 2) & 3) << 6) | (((lane >> 4) & 1) << 5) | (((lane >> 5) & 1) << 8); }
constexpr int v_rd_off(int d0, int ks, int half) { return d0 * 512 + ks * 4096 + half * 2048; }
template <int OFF> __device__ __forceinline__ s16x4 tr_read(int vb) {
  s16x4 r; asm volatile("ds_read_b64_tr_b16 %0, %1 offset:%2" : "=&v"(r) : "v"(vb), "i"(OFF) : "memory"); return r;
}
template <int D0> __device__ __forceinline__ void pv_one(f32x16& od, int vb, bf16x8 pa0, bf16x8 pa1, bf16x8 pa2, bf16x8 pa3) {
  const s16x4 l0 = tr_read<v_rd_off(D0, 0, 0)>(vb), h0 = tr_read<v_rd_off(D0, 0, 1)>(vb), l1 = tr_read<v_rd_off(D0, 1, 0)>(vb), h1 = tr_read<v_rd_off(D0, 1, 1)>(vb);
  const s16x4 l2 = tr_read<v_rd_off(D0, 2, 0)>(vb), h2 = tr_read<v_rd_off(D0, 2, 1)>(vb), l3 = tr_read<v_rd_off(D0, 3, 0)>(vb), h3 = tr_read<v_rd_off(D0, 3, 1)>(vb);
  asm volatile("s_waitcnt lgkmcnt(0)" ::: "memory"); SBAR();
#define PK(L, H) (bf16x8){L[0], L[1], L[2], L[3], H[0], H[1], H[2], H[3]}
  od = __builtin_amdgcn_mfma_f32_32x32x16_bf16(pa0, PK(l0, h0), od, 0, 0, 0);
  od = __builtin_amdgcn_mfma_f32_32x32x16_bf16(pa1, PK(l1, h1), od, 0, 0, 0);
  od = __builtin_amdgcn_mfma_f32_32x32x16_bf16(pa2, PK(l2, h2), od, 0, 0, 0);
  od = __builtin_amdgcn_mfma_f32_32x32x16_bf16(pa3, PK(l3, h3), od, 0, 0, 0);
#undef PK
}
__device__ __forceinline__ void pv_d0(f32x16* o, int vb, bf16x8 pa0, bf16x8 pa1, bf16x8 pa2, bf16x8 pa3) {
  pv_one<0>(o[0], vb, pa0, pa1, pa2, pa3); pv_one<1>(o[1], vb, pa0, pa1, pa2, pa3); pv_one<2>(o[2], vb, pa0, pa1, pa2, pa3); pv_one<3>(o[3], vb, pa0, pa1, pa2, pa3);
}

template <typename TQ>
__device__ __forceinline__ void attn_dense_body(const TQ* __restrict__ Qb, const bf16* __restrict__ Kh, const bf16* __restrict__ Vh,
                                                unsigned short* __restrict__ Ob, int seq, char* lds, const float* __restrict__ gq, int tok0) {
  using St = Stage<bf16>; using SQ = Stage<TQ>;
  int tid_o = threadIdx.x; asm volatile("" : "+v"(tid_o));
  const int tid = tid_o, wid = tid >> 6, lane = tid & 63, r32 = lane & 31, hi = lane >> 5;
  bf16* V_lds = (bf16*)lds; bf16* K_lds = (bf16*)(lds + 2 * SHM_V);
  float* ws = (float*)(lds + 2 * SHM_V + 2 * SHM_K) + wid * 64; float* li_l = ws; float* al_l = ws + 32;
  float m_reg = -1e30f, l_reg = 0; f32x16 o[4] = {}; bf16x8 qr[8];
  const TQ* Qw = Qb + (long)(wid * QBLK + r32) * LDQ + hi * 8;
#ifdef ATT_QFUSE
  { float xq[8][8];
#pragma unroll
    for (int d0 = 0; d0 < 8; ++d0) { const u32x4 w = *reinterpret_cast<const u32x4*>(Qw + d0 * 16);
      xq[d0][0] = __uint_as_float(w[0] << 16); xq[d0][1] = __uint_as_float(w[0] & 0xffff0000u); xq[d0][2] = __uint_as_float(w[1] << 16); xq[d0][3] = __uint_as_float(w[1] & 0xffff0000u);
      xq[d0][4] = __uint_as_float(w[2] << 16); xq[d0][5] = __uint_as_float(w[2] & 0xffff0000u); xq[d0][6] = __uint_as_float(w[3] << 16); xq[d0][7] = __uint_as_float(w[3] & 0xffff0000u); }
    float ss = 0.f;
#pragma unroll
    for (int d0 = 0; d0 < 8; ++d0)
#pragma unroll
      for (int e = 0; e < 8; ++e) ss += xq[d0][e] * xq[d0][e];
    ss += __shfl_xor(ss, 32);
    const float rs = rsqrtf(ss * (1.f / 128.f) + 1e-6f);
#pragma unroll
    for (int d0 = 0; d0 < 8; ++d0) { const float* gp = gq + d0 * 16 + hi * 8;
#pragma unroll
      for (int e = 0; e < 8; ++e) xq[d0][e] *= rs * gp[e]; }
    if (tok0 >= 0) { const int n = tok0 + wid * QBLK + r32;
#pragma unroll
      for (int a = 0; a < 2; ++a) { const float pos = (float)(a == 0 ? (n >> 6) : (n & 63));
#pragma unroll
        for (int dd = 0; dd < 2; ++dd)
#pragma unroll
          for (int e = 0; e < 8; ++e) { const int i = dd * 16 + hi * 8 + e;
            const float ang = pos * exp2f(-(float)(2 * i) * (13.287712379549449f / 64.f)); const float kf = rintf(ang * 0.15915494309189535f);
            float rr = fmaf(-kf, 6.2831854820251465f, ang); rr = fmaf(-kf, -1.7484555e-7f, rr); const float cs = __cosf(rr), sn = __sinf(rr);
            const float y0 = xq[a * 4 + dd][e], y1 = xq[a * 4 + 2 + dd][e];
            xq[a * 4 + dd][e] = y0 * cs - y1 * sn; xq[a * 4 + 2 + dd][e] = y1 * cs + y0 * sn; } } }
#pragma unroll
    for (int d0 = 0; d0 < 8; ++d0) { u32x4 w = {cvtpk(xq[d0][0], xq[d0][1]), cvtpk(xq[d0][2], xq[d0][3]), cvtpk(xq[d0][4], xq[d0][5]), cvtpk(xq[d0][6], xq[d0][7])}; qr[d0] = *reinterpret_cast<bf16x8*>(&w); } }
#else
  (void)gq; (void)tok0;
#pragma unroll
  for (int d0 = 0; d0 < 8; ++d0) qr[d0] = SQ::tobf(SQ::ld8(Qw + d0 * 16));
#endif
  const int sr = tid >> 4, sc = (tid & 15) * 8, vst0 = v_st(sr, sc), vst1 = v_st(32 + sr, sc);
  const int vb0 = (int)(uintptr_t)V_lds + v_rd_base(lane);
  struct { typename St::T vs0, vs1, ks0, ks1; } sr_[SDEPTH];
#define SLOAD(i, k0) do { sr_[i].vs0 = St::ld8(&Vh[(long)((k0) + sr) * LDK + sc]); sr_[i].vs1 = St::ld8(&Vh[(long)((k0) + 32 + sr) * LDK + sc]); \
    sr_[i].ks0 = St::ld8(&Kh[(long)((k0) + sr) * LDK + sc]); sr_[i].ks1 = St::ld8(&Kh[(long)((k0) + 32 + sr) * LDK + sc]); } while (0)
#define SWRITE(b, i) do { *(bf16x8*)((char*)V_lds + (b) * SHM_V + vst0) = St::tobf(sr_[i].vs0);          \
    *(bf16x8*)((char*)V_lds + (b) * SHM_V + vst1) = St::tobf(sr_[i].vs1); int kc = sc * 2;               \
    *(bf16x8*)((char*)K_lds + (b) * SHM_K + KSWZ(sr, kc)) = St::tobf(sr_[i].ks0);                       \
    *(bf16x8*)((char*)K_lds + (b) * SHM_K + KSWZ(32 + sr, kc)) = St::tobf(sr_[i].ks1); } while (0)
#define SWAIT() do { if constexpr (SDEPTH == 2) asm volatile("s_waitcnt vmcnt(4)" ::: "memory"); else asm volatile("s_waitcnt vmcnt(0)" ::: "memory"); } while (0)
#define RESC(a) do { if (__any((a) < 1.f)) { if (hi == 0) al_l[r32] = (a); asm volatile("s_waitcnt lgkmcnt(0)" ::: "memory"); \
    for (int d = 0; d < 4; ++d) for (int r = 0; r < 16; ++r) o[d][r] *= al_l[crow(r, hi)]; } } while (0)
  f32x16 pA0, pA1, pB0, pB1; float mnA, mnB, alA, alB; bf16x8 pa0, pa1, pa2, pa3; const int NT = seq / KVBLK;
  constexpr int SE = 0, SO = SDEPTH - 1;
  SLOAD(SE, 0); asm volatile("s_waitcnt vmcnt(0)" ::: "memory"); SWRITE(0, SE); __syncthreads();
  qkt(pA0, pA1, K_lds, qr, r32, hi); partialSM(pA0, pA1, m_reg, mnA, alA);
  SLOAD(SO, KVBLK); if constexpr (SDEPTH == 2) { if (2 < NT) SLOAD(SE, 2 * KVBLK); }
  SWAIT(); SWRITE(1, SO); __syncthreads();
  for (int j = 1; j + 1 < NT; j += 2) {
    SBAR(); qkt(pB0, pB1, (bf16*)((char*)K_lds + SHM_K), qr, r32, hi);
    finishSM(pA0, pA1, alA, l_reg, pa0, pa1, pa2, pa3); SBAR();
    SLOAD(SO, (j + SDEPTH) * KVBLK); SBAR();
    pv_d0(o, vb0, pa0, pa1, pa2, pa3); partialSM(pB0, pB1, m_reg, mnB, alB);
    __syncthreads(); SWAIT(); SWRITE(0, SE);
    RESC(alB); __syncthreads();
    SBAR(); qkt(pA0, pA1, K_lds, qr, r32, hi);
    finishSM(pB0, pB1, alB, l_reg, pa0, pa1, pa2, pa3); SBAR();
    if (SDEPTH == 1 || j + 3 < NT) SLOAD(SE, (j + 1 + SDEPTH) * KVBLK); SBAR();
    pv_d0(o, vb0 + (int)SHM_V, pa0, pa1, pa2, pa3); partialSM(pA0, pA1, m_reg, mnA, alA);
    __syncthreads(); SWAIT(); SWRITE(1, SO);
    RESC(alA); __syncthreads();
  }
  SBAR(); qkt(pB0, pB1, (bf16*)((char*)K_lds + SHM_K), qr, r32, hi);
  finishSM(pA0, pA1, alA, l_reg, pa0, pa1, pa2, pa3); SBAR();
  pv_d0(o, vb0, pa0, pa1, pa2, pa3); partialSM(pB0, pB1, m_reg, mnB, alB);
  __syncthreads(); RESC(alB);
  finishSM(pB0, pB1, alB, l_reg, pa0, pa1, pa2, pa3); SBAR();
  pv_d0(o, vb0 + (int)SHM_V, pa0, pa1, pa2, pa3);
  if (hi == 0) li_l[r32] = l_reg; asm volatile("s_waitcnt lgkmcnt(0)" ::: "memory");
  float rli[16];
#pragma unroll
  for (int r = 0; r < 16; ++r) rli[r] = __builtin_amdgcn_rcpf(li_l[crow(r, hi)]);
  unsigned short* Ow = Ob + (long)(wid * QBLK) * LDO;
#pragma unroll
  for (int r = 0; r < 16; ++r) { int orow = crow(r, hi);
    for (int d0 = 0; d0 < 4; ++d0) Ow[(long)orow * LDO + d0 * 32 + r32] = f2bf(o[d0][r] * rli[r]); }
#undef SLOAD
#undef SWRITE
#undef SWAIT
#undef RESC
}

#define XB_TMO      128
#define XB_XCNT(j)  (256  + 64 * (j))
#define XB_XSUB(j)  (1280 + 64 * (j))
#define XB_XGEN(j)  (2304 + 64 * (j))
#define XB_TOP      3328
#define XB_TOPGEN   3392
#define XCD_BAR_WORDS 3456
#define XB_SPIN_CAP (1u << 18)

__device__ __forceinline__ unsigned xb_ld(unsigned* p)              { return __hip_atomic_load(p, __ATOMIC_RELAXED, __HIP_MEMORY_SCOPE_AGENT); }
__device__ __forceinline__ unsigned xb_add(unsigned* p, unsigned v) { return __hip_atomic_fetch_add(p, v, __ATOMIC_RELAXED, __HIP_MEMORY_SCOPE_AGENT); }
__device__ __forceinline__ unsigned xb_xcc_id() { return (unsigned)__builtin_amdgcn_s_getreg((3 << 11) | 20) & 0xFu; }
#define XB_SPIN(cond, bar) do { unsigned _sp = 0; while (cond) { __builtin_amdgcn_s_sleep(1); \
    if ((++_sp & 255u) == 0u) { if (xb_ld(&(bar)[XB_TMO])) break; if (_sp > XB_SPIN_CAP) { atomicAdd(&(bar)[XB_TMO], 1u); break; } } } } while (0)

struct XcdBarrier {
    unsigned* bar; unsigned x;
    volatile LAS unsigned* st;
};

__device__ __forceinline__ XcdBarrier xcd_barrier_post(unsigned* bar, volatile LAS unsigned* st) {
    XcdBarrier b; b.bar = bar; b.x = xb_xcc_id(); b.st = st;
    if (threadIdx.x == 0) (void)xb_add(&bar[XB_XCNT(b.x)], 1u);
    return b;
}
__device__ __forceinline__ void xcd_barrier_complete(unsigned* bar, unsigned x, unsigned& nloc, unsigned& nx) {
    const unsigned G = gridDim.x * gridDim.y * gridDim.z;
    unsigned sum, cnt, mine, sp = 0u;
    for (;;) {
        sum = 0u; cnt = 0u; mine = 0u;
#pragma unroll
        for (unsigned j = 0; j < 16; ++j) { const unsigned c = xb_ld(&bar[XB_XCNT(j)]); sum += c; cnt += (c > 0u) ? 1u : 0u; mine = (j == x) ? c : mine; }
        if (sum == G) break;
        __builtin_amdgcn_s_sleep(1);
        if ((++sp & 255u) == 0u) { if (xb_ld(&bar[XB_TMO])) break; if (sp > XB_SPIN_CAP) { atomicAdd(&bar[XB_TMO], 1u); break; } }
    }
    nloc = mine > 0u ? mine : 1u; nx = cnt > 0u ? cnt : 1u;
}

__device__ __forceinline__ void xcd_barrier(const XcdBarrier& b) {
    asm volatile("s_waitcnt vmcnt(0)" ::: "memory");
    __syncthreads();
    if (threadIdx.x == 0) {
        unsigned* bar = b.bar;
        __builtin_amdgcn_s_waitcnt(0);
        unsigned nloc = b.st[0], nx = b.st[1];
        if (nloc == 0u) { xcd_barrier_complete(bar, b.x, nloc, nx); b.st[0] = nloc; b.st[1] = nx; }
        const unsigned old = xb_add(&bar[XB_XSUB(b.x)], 1u);
        const unsigned gen = old / nloc;
        if (old + 1u == (gen + 1u) * nloc) {
            __builtin_amdgcn_fence(__ATOMIC_RELEASE, "agent");
            asm volatile("s_waitcnt vmcnt(0)" ::: "memory");
            const unsigned og = xb_add(&bar[XB_TOP], 1u);
            const unsigned tg = og / nx;
            if (og + 1u == (tg + 1u) * nx) xb_add(&bar[XB_TOPGEN], 1u);
            else XB_SPIN(xb_ld(&bar[XB_TOPGEN]) == tg, bar);
            __builtin_amdgcn_fence(__ATOMIC_ACQUIRE, "agent");
            xb_add(&bar[XB_XGEN(b.x)], 1u);
            asm volatile("s_waitcnt vmcnt(0)" ::: "memory");
        } else {
            XB_SPIN(xb_ld(&bar[XB_XGEN(b.x)]) == gen, bar);
            __builtin_amdgcn_fence(__ATOMIC_ACQUIRE, "agent");
            asm volatile("s_waitcnt vmcnt(0)" ::: "memory");
        }
    }
    __syncthreads();
}

typedef short bf16x8_t __attribute__((ext_vector_type(8)));
struct Params { const float* in[19]; float* out; unsigned char* ws; };
enum { I_X = 0, I_C, I_CTX, I_CCTX, I_WMOD, I_BMOD, I_GNORM, I_WIN, I_GQK, I_WS, I_BS, I_CONVW, I_CONVB, I_LRUW, I_LRUB, I_LRULAM, I_WOUT, I_WFI, I_WFO };

__device__ __forceinline__ void transpose_item(const float* __restrict__ W, int ldw, bf16_t* __restrict__ dst, int ldk, LAS float* scr, int lane) {
#pragma unroll 8
    for (int i = 0; i < 32; ++i) { const int kk = 2 * i + (lane >> 5); scr[kk * 33 + (lane & 31)] = __builtin_nontemporal_load(W + (size_t)kk * ldw + (lane & 31)); }
    LDS_WAIT();
    const int c = lane & 7;
#pragma unroll
    for (int j = 0; j < 4; ++j) { const int n = (lane >> 3) + 8 * j; const LAS float* s = scr + (8 * c) * 33 + n;
        u32x4_t o; o.x = pk2bf(s[0 * 33], s[1 * 33]); o.y = pk2bf(s[2 * 33], s[3 * 33]); o.z = pk2bf(s[4 * 33], s[5 * 33]); o.w = pk2bf(s[6 * 33], s[7 * 33]);
        *(u32x4_t*)(dst + (size_t)n * ldk + 8 * c) = o; }
    LDS_WAIT();
}

__device__ __forceinline__ void mod_item(int it, const Params& p, LAS float* lds, int tid_in, int wid, int lane_in) {
    int tid = tid_in; asm volatile("" : "+v"(tid)); const int lane = tid & 63; (void)lane_in;
    const int l = it / 96, cgp = it % 96;
    const float* cv = p.in[I_C]; const float* cc = p.in[I_CCTX];
    for (int e = tid; e < 9 * DM; e += 512) { const int r = e >> 11, k = e & (DM - 1); const float v = r < 8 ? cv[r * DM + k] : cc[k]; lds[k * 12 + r] = v * sigmoid_f(v); }
    __syncthreads();
    const float* W = p.in[I_WMOD] + (size_t)l * DM * (6 * DM) + cgp * 128 + lane * 2;
    float acc[9][2];
#pragma unroll
    for (int r = 0; r < 9; ++r) { acc[r][0] = 0.f; acc[r][1] = 0.f; }
    const int kb = wid * 256;
#pragma unroll 16
    for (int k = 0; k < 256; ++k) {
        const f32x2_t w = __builtin_nontemporal_load((const f32x2_t*)(W + (size_t)(kb + k) * (6 * DM)));
        const LAS float* a = lds + (kb + k) * 12;
        const f32x4_t a0 = *(const LAS f32x4_t*)a, a1 = *(const LAS f32x4_t*)(a + 4); const float a8 = a[8];
        acc[0][0] += a0.x * w.x; acc[0][1] += a0.x * w.y; acc[1][0] += a0.y * w.x; acc[1][1] += a0.y * w.y;
        acc[2][0] += a0.z * w.x; acc[2][1] += a0.z * w.y; acc[3][0] += a0.w * w.x; acc[3][1] += a0.w * w.y;
        acc[4][0] += a1.x * w.x; acc[4][1] += a1.x * w.y; acc[5][0] += a1.y * w.x; acc[5][1] += a1.y * w.y;
        acc[6][0] += a1.z * w.x; acc[6][1] += a1.z * w.y; acc[7][0] += a1.w * w.x; acc[7][1] += a1.w * w.y;
        acc[8][0] += a8 * w.x; acc[8][1] += a8 * w.y;
    }
    __syncthreads();
#pragma unroll
    for (int r = 0; r < 9; ++r) { lds[(wid * 18 + r * 2 + 0) * 64 + lane] = acc[r][0]; lds[(wid * 18 + r * 2 + 1) * 64 + lane] = acc[r][1]; }
    __syncthreads();
    float* MOD = (float*)(p.ws + WS_MOD);
    for (int o = tid; o < 9 * 128; o += 512) { const int r = o >> 7, col = o & 127, q = r * 2 + (col & 1), ls = col >> 1;
        float s = p.in[I_BMOD][l * (6 * DM) + cgp * 128 + col];
#pragma unroll
        for (int w = 0; w < 8; ++w) s += lds[(w * 18 + q) * 64 + ls];
        MOD[(size_t)(l * 9 + r) * (6 * DM) + cgp * 128 + col] = s; }
    __syncthreads();
}

constexpr int NI_WIN = 32 * 112, NI_WOUT = 32 * 64, NI_WFI = 32 * 352, NI_WFO = 88 * 64, NI_LRU = 128, PL = NI_WIN + NI_WOUT + NI_WFI + NI_WFO + NI_LRU;
__device__ __forceinline__ void convert_item(const Params& p, int l, int r, LAS float* scr, int lane) {
    const float* src; bf16_t* dst; int ldw, ldk;
    if (r < NI_WIN) { const int kb = r / 112, nb = r % 112; ldw = INC; ldk = DM;
        src = p.in[I_WIN] + (size_t)l * DM * INC + (size_t)(64 * kb) * INC + 32 * nb;
        dst = (bf16_t*)(p.ws + WS_WIN + l * SZ_WIN) + (size_t)(32 * nb) * DM + 64 * kb; }
    else if ((r -= NI_WIN) < NI_WOUT) { const int kb = r / 64, nb = r % 64; ldw = DM; ldk = DM;
        src = p.in[I_WOUT] + (size_t)l * DM * DM + (size_t)(64 * kb) * DM + 32 * nb;
        dst = (bf16_t*)(p.ws + WS_WOUT + l * SZ_WOUT) + (size_t)(32 * nb) * DM + 64 * kb; }
    else if ((r -= NI_WOUT) < NI_WFI) { const int kb = r / 352, nb = r % 352; ldw = 2 * DFF; ldk = DM;
        const int n0 = 32 * nb, half = n0 / DFF, idx = n0 - half * DFF, drow = (idx >> 7) * 256 + half * 128 + (idx & 127);
        src = p.in[I_WFI] + (size_t)l * DM * 2 * DFF + (size_t)(64 * kb) * (2 * DFF) + n0;
        dst = (bf16_t*)(p.ws + WS_WFI + l * SZ_WFI) + (size_t)drow * DM + 64 * kb; }
    else if ((r -= NI_WFI) < NI_WFO) { const int kb = r / 64, nb = r % 64; ldw = DM; ldk = DFF;
        src = p.in[I_WFO] + (size_t)l * DFF * DM + (size_t)(64 * kb) * DM + 32 * nb;
        dst = (bf16_t*)(p.ws + WS_WFO + l * SZ_WFO) + (size_t)(32 * nb) * DFF + 64 * kb; }
    else { r -= NI_WFO; const int mat = r >> 3, sub = r & 7, kb = sub >> 2, nb = sub & 3; ldw = 128; ldk = 128;
        src = p.in[I_LRUW] + (size_t)(l * 16 + mat) * 16384 + (size_t)(64 * kb) * 128 + 32 * nb;
        dst = (bf16_t*)(p.ws + WS_LRUW + l * SZ_LRUW) + (size_t)mat * 16384 + (size_t)(32 * nb) * 128 + 64 * kb; }
    transpose_item(src, ldw, dst, ldk, scr, lane);
}
__device__ __forceinline__ void convert_layer(const Params& p, int l, int it0, int itstep, int itend, LAS unsigned char* lds, int wid, int lane) {
    LAS float* scr = (LAS float*)lds + wid * (64 * 33);
    for (int it = it0; it < itend; it += itstep) convert_item(p, l, it, scr, lane);
}
__device__ __forceinline__ void phase0(const Params& p, LAS unsigned char* lds, int tid, int wid, int lane) {
    for (int it = blockIdx.x; it < 192; it += gridDim.x) mod_item(it, p, (LAS float*)lds, tid, wid, lane);
    const int gw = blockIdx.x * 8 + wid, NGW = gridDim.x * 8;
    int it0 = gw, itstep = NGW, itend = PL;
    if ((int)gridDim.x > 192) { const int n1 = min(((int)gridDim.x - 192) * 8 * 19, PL);
        if ((int)blockIdx.x >= 192) { it0 = ((int)blockIdx.x - 192) * 8 + wid; itstep = ((int)gridDim.x - 192) * 8; itend = n1; }
        else { it0 = n1 + gw; itstep = 192 * 8; } }
    convert_layer(p, 0, it0, itstep, itend, lds, wid, lane);
    bf16_t* WSB = (bf16_t*)(p.ws + WS_WSB);
    for (int i = blockIdx.x * 512 + tid; i < NLAYER * 4 * 128 * 128; i += gridDim.x * 512) WSB[i] = f2bf(p.in[I_WS][i]);
}

__device__ __forceinline__ void load_row(const float* rp, int lane, f32x4_t (&v)[8]) {
    const f32x4_t* q = (const f32x4_t*)rp + lane;
#pragma unroll
    for (int j = 0; j < 8; ++j) v[j] = __builtin_nontemporal_load(q + 64 * j);
}
__device__ __forceinline__ float row_rstd(const f32x4_t (&v)[8]) {
    float s = 0.f;
#pragma unroll
    for (int j = 0; j < 8; ++j) s += (v[j].x * v[j].x + v[j].y * v[j].y) + (v[j].z * v[j].z + v[j].w * v[j].w);
    return rsqrtf(wave_sum(s) * (1.f / DM) + EPS);
}
__device__ __forceinline__ void mod_store(const f32x4_t (&v)[8], float r, const float* g, const float* sh, const float* sc, bf16_t* dst, int lane) {
#pragma unroll
    for (int j = 0; j < 8; ++j) { const int col = 4 * (64 * j + lane);
        const f32x4_t g4 = *(const f32x4_t*)(g + col), sh4 = *(const f32x4_t*)(sh + col), sc4 = *(const f32x4_t*)(sc + col);
        const f32x4_t h = (v[j] * r * g4) * (1.f + sc4) + sh4;
        u32x2_t w; w.x = pk2bf(h.x, h.y); w.y = pk2bf(h.z, h.w);
        *(u32x2_t*)(dst + col) = w; }
}
__device__ __forceinline__ void load_vec8(const float* v, int lane, f32x4_t (&o)[8]) {
#pragma unroll
    for (int j = 0; j < 8; ++j) o[j] = *(const f32x4_t*)(v + 4 * (64 * j + lane));
}
__device__ __forceinline__ void store_h(const f32x4_t (&x)[8], float r, const f32x4_t (&cA)[8], const f32x4_t (&cS)[8], bf16_t* dst, int lane) {
#pragma unroll
    for (int j = 0; j < 8; ++j) { const f32x4_t h = (x[j] * r) * cA[j] + cS[j];
        u32x2_t w; w.x = pk2bf(h.x, h.y); w.y = pk2bf(h.z, h.w);
        *(u32x2_t*)(dst + 4 * (64 * j + lane)) = w; }
}
__device__ __forceinline__ void phaseA(const Params& p, int gw, int NGW, int lane) {
    const float* MOD = (const float*)(p.ws + WS_MOD); bf16_t* H = (bf16_t*)(p.ws + WS_HBUF);
    const int R = (MT + NGW - 1) / NGW; int cur = -1; f32x4_t cA[8], cS[8], v[8], vn[8];
    const int m0 = gw * R;
    if (m0 < MT) load_row(m0 < ML ? p.in[I_X] + (size_t)m0 * DM : p.in[I_CTX] + (size_t)(m0 - ML) * DM, lane, v);
    for (int k = 0; k < R; ++k) { const int m = m0 + k; if (m >= MT) break;
        const int mn = m + 1; const bool has_n = (k + 1 < R) && (mn < MT);
        if (has_n) load_row(mn < ML ? p.in[I_X] + (size_t)mn * DM : p.in[I_CTX] + (size_t)(mn - ML) * DM, lane, vn);
        const bool lat = m < ML; const int bi = lat ? (m >> 11) : 8;
        if (bi != cur) { cur = bi; const float* md = MOD + (size_t)bi * (6 * DM); f32x4_t g[8], sc[8]; load_vec8(p.in[I_GNORM], lane, g); load_vec8(md + DM, lane, sc); load_vec8(md, lane, cS);
#pragma unroll
            for (int j = 0; j < 8; ++j) cA[j] = g[j] * (1.f + sc[j]); }
        store_h(v, row_rstd(v), cA, cS, H + (size_t)m * DM, lane);
        if (has_n) {
#pragma unroll
            for (int j = 0; j < 8; ++j) v[j] = vn[j]; }
    }
}
template <bool XIN32, bool XOUT32>
__device__ __forceinline__ void row_update(const Params& p, int mcount, const float* modl, int gt_off, const float* gy, bool do_next, const float* gnext, const float* modn, int sh_off, int sc_off,
                                           int gw, int NGW, int lane) {
    const bf16_t* Y = (const bf16_t*)(p.ws + WS_YBUF); bf16_t* H = (bf16_t*)(p.ws + WS_HBUF); bf16_t* XB = (bf16_t*)(p.ws + WS_XB);
    const int R = (mcount + NGW - 1) / NGW; int cur = -1; f32x4_t c1[8], cA[8], cS[8];
    bool have_y = false, have_x = false; u32x2_t yn[8], xn[8];
    for (int k = 0; k < R; ++k) { const int m = gw * R + k; if (m >= mcount) break;
        const bool lat = m < ML; const int bi = lat ? (m >> 11) : 8;
        if (bi != cur) { cur = bi; f32x4_t a[8], b[8];
            load_vec8(modl + (size_t)bi * (6 * DM) + gt_off, lane, a); load_vec8(gy, lane, b);
#pragma unroll
            for (int j = 0; j < 8; ++j) c1[j] = a[j] * b[j];
            if (do_next) { const float* mn = modn + (size_t)bi * (6 * DM); load_vec8(gnext, lane, a); load_vec8(mn + sc_off, lane, b); load_vec8(mn + sh_off, lane, cS);
#pragma unroll
                for (int j = 0; j < 8; ++j) cA[j] = a[j] * (1.f + b[j]); } }
        f32x4_t y[8], x[8];
        if (lat) {
            if (!have_y) { const u32x2_t* yq = (const u32x2_t*)(Y + (size_t)m * DM) + lane;
#pragma unroll
                for (int j = 0; j < 8; ++j) yn[j] = __builtin_nontemporal_load(yq + 64 * j); }
#pragma unroll
            for (int j = 0; j < 8; ++j) y[j] = (f32x4_t){bflo(yn[j].x), bfhi(yn[j].x), bflo(yn[j].y), bfhi(yn[j].y)}; }
        else { const u32x2_t* yp = (const u32x2_t*)((const bf16_t*)(p.ws + WS_YPART) + (size_t)(m - ML) * DM) + lane;
          constexpr size_t PS = (size_t)MC * DM / 4;
#pragma unroll
          for (int j = 0; j < 8; ++j) { const u32x2_t a = __builtin_nontemporal_load(yp + 64 * j), b = __builtin_nontemporal_load(yp + 64 * j + PS), c = __builtin_nontemporal_load(yp + 64 * j + 2 * PS), d = __builtin_nontemporal_load(yp + 64 * j + 3 * PS);
              y[j] = ((f32x4_t){bflo(a.x), bfhi(a.x), bflo(a.y), bfhi(a.y)} + (f32x4_t){bflo(b.x), bfhi(b.x), bflo(b.y), bfhi(b.y)})
                   + ((f32x4_t){bflo(c.x), bfhi(c.x), bflo(c.y), bfhi(c.y)} + (f32x4_t){bflo(d.x), bfhi(d.x), bflo(d.y), bfhi(d.y)}); } }
        if (XIN32) load_row(lat ? p.in[I_X] + (size_t)m * DM : p.in[I_CTX] + (size_t)(m - ML) * DM, lane, x);
        else {
            if (!have_x) { const u32x2_t* xq = (const u32x2_t*)(XB + (size_t)m * DM) + lane;
#pragma unroll
                for (int j = 0; j < 8; ++j) xn[j] = __builtin_nontemporal_load(xq + 64 * j); }
#pragma unroll
            for (int j = 0; j < 8; ++j) x[j] = (f32x4_t){bflo(xn[j].x), bfhi(xn[j].x), bflo(xn[j].y), bfhi(xn[j].y)}; }
        { const int mn = m + 1; const bool nx = (k + 1 < R) && (mn < mcount);
          have_y = nx && (mn < ML); have_x = nx && !XIN32;
          if (have_y) { const u32x2_t* yq = (const u32x2_t*)(Y + (size_t)mn * DM) + lane;
#pragma unroll
              for (int j = 0; j < 8; ++j) yn[j] = __builtin_nontemporal_load(yq + 64 * j); }
          if (have_x) { const u32x2_t* xq = (const u32x2_t*)(XB + (size_t)mn * DM) + lane;
#pragma unroll
              for (int j = 0; j < 8; ++j) xn[j] = __builtin_nontemporal_load(xq + 64 * j); } }
        const float ry = row_rstd(y);
#pragma unroll
        for (int j = 0; j < 8; ++j) { x[j] = x[j] + c1[j] * (y[j] * ry);
            if (XOUT32) __builtin_nontemporal_store(x[j], (f32x4_t*)(p.out + (size_t)m * DM + 4 * (64 * j + lane)));
            else { u32x2_t w; w.x = pk2bf(x[j].x, x[j].y); w.y = pk2bf(x[j].z, x[j].w); __builtin_nontemporal_store(w, (u32x2_t*)(XB + (size_t)m * DM + 4 * (64 * j + lane))); } }
        if (do_next) store_h(x, row_rstd(x), cA, cS, H + (size_t)m * DM, lane);
    }
}

#ifdef ATT_QFUSE
#define QK_PS0 2
#else
#define QK_PS0 0
#endif
__device__ __forceinline__ void qk_rows(const Params& p, int l, int gw, int NGW, int lane) {
    bf16_t* P = (bf16_t*)(p.ws + WS_PBUF); bf16_t* KB = (bf16_t*)(p.ws + WS_KBUF); bf16_t* VB = (bf16_t*)(p.ws + WS_VBUF);
    const float* gqk = p.in[I_GQK] + l * 256;
    const int hs = lane >> 4, sub = lane & 15, a = sub >> 3;
    const float sgn = (sub & 4) ? 1.f : -1.f;
    float invf[8], gq[8], gk[8];
#pragma unroll
    for (int e = 0; e < 8; ++e) { const int i = (sub & 3) * 8 + e; invf[e] = exp2f(-(float)(2 * i) * (13.287712379549449f / 64.f)); gq[e] = gqk[sub * 8 + e]; gk[e] = gqk[128 + sub * 8 + e]; }
    u32x4_t w[3];
    if (gw < MT) {
#pragma unroll
        for (int ps = QK_PS0; ps < 3; ++ps) w[ps] = *(const u32x4_t*)(P + (size_t)gw * INC + ps * 512 + lane * 8);
    }
    for (int m = gw; m < MT; m += NGW) {
        u32x4_t wn[3]; const int mn = m + NGW;
        if (mn < MT) {
#pragma unroll
            for (int ps = QK_PS0; ps < 3; ++ps) wn[ps] = *(const u32x4_t*)(P + (size_t)mn * INC + ps * 512 + lane * 8);
        }
        const bool lat = m < ML; int b, keypos; float cs[8], sn[8];
        if (lat) { b = m >> 11; const int n = m & (SEQ - 1); keypos = CTXL + n; const float pos = (float)(a == 0 ? (n >> 6) : (n & 63));
#pragma unroll
            for (int e = 0; e < 8; ++e) { const float ang = pos * invf[e]; const float kf = rintf(ang * 0.15915494309189535f);
                float rr = fmaf(-kf, 6.2831854820251465f, ang); rr = fmaf(-kf, -1.7484555e-7f, rr); cs[e] = __cosf(rr); sn[e] = __sinf(rr); } }
        else { const int mc = m - ML; b = mc >> 8; keypos = mc & (CTXL - 1);
#pragma unroll
            for (int e = 0; e < 8; ++e) { cs[e] = 1.f; sn[e] = 0.f; } }
        bf16_t* pr = P + (size_t)m * INC;
#pragma unroll
        for (int ps = QK_PS0; ps < 3; ++ps) {
            if (ps == 2 && hs >= 2) {
                *(u32x4_t*)(VB + ((size_t)(b * 2 + (hs - 2)) * SKV + keypos) * 128 + sub * 8) = w[ps];
            } else {
                float x[8]; x[0] = bflo(w[ps].x); x[1] = bfhi(w[ps].x); x[2] = bflo(w[ps].y); x[3] = bfhi(w[ps].y); x[4] = bflo(w[ps].z); x[5] = bfhi(w[ps].z); x[6] = bflo(w[ps].w); x[7] = bfhi(w[ps].w);
                float ss = 0.f;
#pragma unroll
                for (int e = 0; e < 8; ++e) ss += x[e] * x[e];
                ss += __shfl_xor(ss, 1); ss += __shfl_xor(ss, 2); ss += __shfl_xor(ss, 4); ss += __shfl_xor(ss, 8);
                const float rs = rsqrtf(ss * (1.f / 128.f) + EPS);
                float o[8];
#pragma unroll
                for (int e = 0; e < 8; ++e) { const float y = x[e] * rs * (ps < 2 ? gq[e] : gk[e]); const float yp = __shfl_xor(y, 4); o[e] = y * cs[e] + sgn * yp * sn[e]; }
                u32x4_t ow; ow.x = pk2bf(o[0], o[1]); ow.y = pk2bf(o[2], o[3]); ow.z = pk2bf(o[4], o[5]); ow.w = pk2bf(o[6], o[7]);
                if (ps < 2) *(u32x4_t*)(pr + ps * 512 + lane * 8) = ow;
                else *(u32x4_t*)(KB + ((size_t)(b * 2 + hs) * SKV + keypos) * 128 + sub * 8) = ow;
            }
        }
#pragma unroll
        for (int ps = QK_PS0; ps < 3; ++ps) w[ps] = wn[ps];
    }
}

constexpr int TS = 136;
__device__ __forceinline__ void tile_mma(f32x4_t (&acc)[8], const LAS bf16_t* X, const LAS bf16_t* Y, int wid, int fr, int fq) {
#pragma unroll
    for (int kk = 0; kk < 4; ++kk) {
        const bf16x8_t av = *(const LAS bf16x8_t*)(X + (16 * wid + fr) * TS + kk * 32 + fq * 8);
#pragma unroll
        for (int jb = 0; jb < 8; ++jb) { const bf16x8_t bv = *(const LAS bf16x8_t*)(Y + (16 * jb + fr) * TS + kk * 32 + fq * 8);
            acc[jb] = __builtin_amdgcn_mfma_f32_16x16x32_bf16(av, bv, acc[jb], 0, 0, 0); }
    }
}
__device__ __forceinline__ void stage_tile(LAS bf16_t* T, const bf16_t* src, int ld, int tid) {
    u32x4_t v[4];
#pragma unroll
    for (int q = 0; q < 4; ++q) { const int idx = tid + 512 * q, row = idx >> 4, c8 = (idx & 15) * 8; v[q] = *(const u32x4_t*)(src + (size_t)row * ld + c8); }
#pragma unroll
    for (int q = 0; q < 4; ++q) { const int idx = tid + 512 * q, row = idx >> 4, c8 = (idx & 15) * 8; *(LAS u32x4_t*)(T + row * TS + c8) = v[q]; }
}

__device__ __forceinline__ void mlp_item(const Params& p, int l, int ck, int g, LAS unsigned char* lds, int tid_in, int wid, int lane_in) {
    int tid = tid_in; asm volatile("" : "+v"(tid)); const int lane = tid & 63; (void)lane_in;
    const bf16_t* P = (const bf16_t*)(p.ws + WS_PBUF); bf16_t* H = (bf16_t*)(p.ws + WS_HBUF);
    LAS bf16_t* X = (LAS bf16_t*)lds; LAS bf16_t* Y = X + 128 * TS;
    const int row0 = ck * 128, fr = lane & 15, fq = lane >> 4;
    u32x4_t vw[2][2], xw[4]; unsigned short uu[4][8]; float bsv[4];
#pragma unroll
    for (int o = 0; o < 2; ++o)
#pragma unroll
        for (int e = 0; e < 2; ++e) vw[o][e] = *(const u32x4_t*)(P + (size_t)(row0 + 2 * lane + e) * INC + (ZM_OFF + 512) + g * 128 + (2 * wid + o) * 8);
    { const bf16_t* src = (const bf16_t*)(p.ws + WS_WSB) + (size_t)(l * 4 + g) * 16384;
#pragma unroll
      for (int q = 0; q < 4; ++q) { const int idx = tid + 512 * q, row = idx >> 4, c8 = (idx & 15) * 8; xw[q] = *(const u32x4_t*)(src + (size_t)row * 128 + c8); } }
    const float* bs = p.in[I_BS] + (l * 4 + g) * 128;
#pragma unroll
    for (int r = 0; r < 4; ++r) { const int pi = 16 * wid + 4 * fq + r; bsv[r] = bs[pi];
        const bf16_t* ur = P + (size_t)(row0 + pi) * INC + ZM_OFF + g * 128;
#pragma unroll
        for (int jb = 0; jb < 8; ++jb) uu[r][jb] = ur[jb * 16 + fr]; }
#pragma unroll
    for (int q = 0; q < 4; ++q) { const int idx = tid + 512 * q, row = idx >> 4, c8 = (idx & 15) * 8; *(LAS u32x4_t*)(X + row * TS + c8) = xw[q]; }
#pragma unroll
    for (int o = 0; o < 2; ++o) { const int c8 = (2 * wid + o) * 8; const u32x4_t a = vw[o][0], b = vw[o][1];
        LAS unsigned* Yd = (LAS unsigned*)(Y + c8 * TS + 2 * lane);
        Yd[0 * (TS / 2)] = pk2bf(gelu_tanh(bflo(a.x)), gelu_tanh(bflo(b.x))); Yd[1 * (TS / 2)] = pk2bf(gelu_tanh(bfhi(a.x)), gelu_tanh(bfhi(b.x)));
        Yd[2 * (TS / 2)] = pk2bf(gelu_tanh(bflo(a.y)), gelu_tanh(bflo(b.y))); Yd[3 * (TS / 2)] = pk2bf(gelu_tanh(bfhi(a.y)), gelu_tanh(bfhi(b.y)));
        Yd[4 * (TS / 2)] = pk2bf(gelu_tanh(bflo(a.z)), gelu_tanh(bflo(b.z))); Yd[5 * (TS / 2)] = pk2bf(gelu_tanh(bfhi(a.z)), gelu_tanh(bfhi(b.z)));
        Yd[6 * (TS / 2)] = pk2bf(gelu_tanh(bflo(a.w)), gelu_tanh(bflo(b.w))); Yd[7 * (TS / 2)] = pk2bf(gelu_tanh(bfhi(a.w)), gelu_tanh(bfhi(b.w))); }
    __syncthreads();
    f32x4_t acc[8];
#pragma unroll
    for (int jb = 0; jb < 8; ++jb) acc[jb] = (f32x4_t){0.f, 0.f, 0.f, 0.f};
    tile_mma(acc, X, Y, wid, fr, fq);
#pragma unroll
    for (int r = 0; r < 4; ++r) { const int pi = 16 * wid + 4 * fq + r;
        bf16_t* orow = H + (size_t)(row0 + pi) * DM + 1024 + g * 128;
#pragma unroll
        for (int jb = 0; jb < 8; ++jb) { const int c = jb * 16 + fr; orow[c] = f2bf(gelu_tanh(bf2f(uu[r][jb])) * (acc[jb][r] + bsv[r])); } }
    __syncthreads();
}

#ifdef PROBE_MASK
#define PROBE_ARGS , unsigned long long& ts_, unsigned long long& tsel_
#define PROBE_PASS , ts_, tsel_
#define ISTAMP(bit) do { const unsigned long long n_ = wall_clock64(); if ((PROBE_MASK) & (1u << (bit))) tsel_ += n_ - ts_; ts_ = n_; } while (0)
#else
#define PROBE_ARGS
#define PROBE_PASS
#define ISTAMP(bit) do {} while (0)
#endif
__device__ __forceinline__ void lru1_item(const Params& p, int l, int ck, int h, int d, LAS unsigned char* lds, int tid_in, int wid, int lane_in PROBE_ARGS) {
    int tid = tid_in; asm volatile("" : "+v"(tid)); const int lane = tid & 63; (void)lane_in;
    const bf16_t* P = (const bf16_t*)(p.ws + WS_PBUF);
    LAS bf16_t* X = (LAS bf16_t*)lds; LAS bf16_t* Y = X + 128 * TS; LAS float* WT = (LAS float*)(lds + 131072 + 64);
    const int fr = lane & 15, fq = lane >> 4;
    int seqbase, L, jc;
    if (ck < 128) { seqbase = (ck >> 4) * SEQ; L = SEQ; jc = ck & 15; } else { const int c2 = ck - 128; seqbase = ML + (c2 >> 1) * CTXL; L = CTXL; jc = c2 & 1; }
    const float* cw = p.in[I_CONVW] + l * 4 * 512 + h * 128; const float* cb = p.in[I_CONVB] + l * 512 + h * 128;
    const bf16_t* LW = (const bf16_t*)(p.ws + WS_LRUW + l * SZ_LRUW);
    const float* lb = p.in[I_LRUB] + (size_t)((l * 2 + d) * 2) * 512 + h * 128; const float* lam = p.in[I_LRULAM] + (l * 2 + d) * 512 + h * 128;
    u32x4_t wga[4], wgx[4];
#pragma unroll
    for (int q = 0; q < 4; ++q) { const int idx = tid + 512 * q, row = idx >> 4, c8 = (idx & 15) * 8;
        wga[q] = *(const u32x4_t*)(LW + (size_t)((d * 2 + 0) * 4 + h) * 16384 + (size_t)row * 128 + c8);
        wgx[q] = *(const u32x4_t*)(LW + (size_t)((d * 2 + 1) * 4 + h) * 16384 + (size_t)row * 128 + c8); }
    {
        const int c8 = (tid & 15) * 8, t0 = tid >> 4;
        f32x4_t w0[4], w1[4];
#pragma unroll
        for (int tap = 0; tap < 4; ++tap) { w0[tap] = *(const f32x4_t*)(cw + tap * 512 + c8); w1[tap] = *(const f32x4_t*)(cw + tap * 512 + c8 + 4); }
        const f32x4_t b0 = *(const f32x4_t*)(cb + c8), b1 = *(const f32x4_t*)(cb + c8 + 4);
#pragma unroll
        for (int hf = 0; hf < 2; ++hf) {
            u32x4_t pw[2][4]; float vm[2][4];
#pragma unroll
            for (int q2 = 0; q2 < 2; ++q2)
#pragma unroll
                for (int tap = 0; tap < 4; ++tap) { const int pos = jc * 128 + t0 + 32 * (2 * hf + q2) + tap - 2, posc = min(max(pos, 0), L - 1);
                    vm[q2][tap] = (pos == posc) ? 1.f : 0.f;
                    pw[q2][tap] = *(const u32x4_t*)(P + (size_t)(seqbase + posc) * INC + ZX_OFF + h * 128 + c8); }
#pragma unroll
            for (int q2 = 0; q2 < 2; ++q2) { f32x4_t x0 = b0, x1 = b1;
#pragma unroll
                for (int tap = 0; tap < 4; ++tap) { const u32x4_t w = pw[q2][tap]; const f32x4_t a0 = w0[tap] * vm[q2][tap], a1 = w1[tap] * vm[q2][tap];
                    x0 += (f32x4_t){bflo(w.x), bfhi(w.x), bflo(w.y), bfhi(w.y)} * a0; x1 += (f32x4_t){bflo(w.z), bfhi(w.z), bflo(w.w), bfhi(w.w)} * a1; }
                u32x4_t o; o.x = pk2bf(x0.x, x0.y); o.y = pk2bf(x0.z, x0.w); o.z = pk2bf(x1.x, x1.y); o.w = pk2bf(x1.z, x1.w);
                *(LAS u32x4_t*)(X + (t0 + 32 * (2 * hf + q2)) * TS + c8) = o; }
        }
    }
    LAS bf16_t* Y2 = Y + 128 * TS;
#pragma unroll
    for (int q = 0; q < 4; ++q) { const int idx = tid + 512 * q, row = idx >> 4, c8 = (idx & 15) * 8; *(LAS u32x4_t*)(Y + row * TS + c8) = wga[q]; *(LAS u32x4_t*)(Y2 + row * TS + c8) = wgx[q]; }
    __syncthreads(); ISTAMP(20);
    float cba[8], cbx[8], clam[8];
#pragma unroll
    for (int jb = 0; jb < 8; ++jb) { const int jj = jb * 16 + fr; cba[jb] = lb[jj]; cbx[jb] = lb[512 + jj]; clam[jb] = lam[jj]; }
    f32x4_t accR[8], accI[8];
#pragma unroll
    for (int jb = 0; jb < 8; ++jb) { accR[jb] = (f32x4_t){0.f, 0.f, 0.f, 0.f}; accI[jb] = (f32x4_t){0.f, 0.f, 0.f, 0.f}; }
    tile_mma(accR, X, Y, wid, fr, fq);
    tile_mma(accI, X, Y2, wid, fr, fq); ISTAMP(21);
    const int src1 = (d == 0 ? lane - 16 : lane + 16) & 63, src2 = (d == 0 ? lane - 32 : lane + 32) & 63;
    const bool v1 = d == 0 ? (fq >= 1) : (fq <= 2), v2 = d == 0 ? (fq >= 2) : (fq <= 1), lastq = d == 0 ? (fq == 3) : (fq == 0);
    float Al[8][4], hl[8][4], Aq[8], hq[8];
#pragma unroll
    for (int jb = 0; jb < 8; ++jb) { const int jj = jb * 16 + fr;
        const float ba = cba[jb], bxb = cbx[jb], sp8 = -8.f * log1pf(expf(-clam[jb]));
        float a4[4], b4[4];
#pragma unroll
        for (int r = 0; r < 4; ++r) {
            const float xv = bf2f(X[(16 * wid + 4 * fq + r) * TS + jj]);
            const float rg = sigmoid_f(accR[jb][r] + ba), ig = sigmoid_f(accI[jb][r] + bxb);
            const float la = sp8 * rg, z = 2.f * la;
            const float om = -z * (1.f + z * (0.5f + z * (0.16666667f + z * (0.041666668f + z * (0.0083333338f + z * 0.0013888889f)))));
            a4[r] = __expf(la); b4[r] = __builtin_amdgcn_sqrtf(om) * (ig * xv); }
        float A, hs;
        if (d == 0) { A = a4[0]; hs = b4[0]; Al[jb][0] = A; hl[jb][0] = hs;
#pragma unroll
            for (int r = 1; r < 4; ++r) { hs = a4[r] * hs + b4[r]; A *= a4[r]; Al[jb][r] = A; hl[jb][r] = hs; } }
        else { A = a4[3]; hs = b4[3]; Al[jb][3] = A; hl[jb][3] = hs;
#pragma unroll
            for (int r = 2; r >= 0; --r) { hs = a4[r] * hs + b4[r]; A *= a4[r]; Al[jb][r] = A; hl[jb][r] = hs; } }
        { const float Ap = __shfl(A, src1), hp = __shfl(hs, src1); if (v1) { hs = A * hp + hs; A = Ap * A; } }
        { const float Ap = __shfl(A, src2), hp = __shfl(hs, src2); if (v2) { hs = A * hp + hs; A = Ap * A; } }
        { const float Ap = __shfl(A, src1), hp = __shfl(hs, src1); Aq[jb] = v1 ? Ap : 1.f; hq[jb] = v1 ? hp : 0.f; }
        if (lastq) { WT[(wid * 128 + jj) * 2 + 0] = A; WT[(wid * 128 + jj) * 2 + 1] = hs; }
    }
    ISTAMP(22); __syncthreads();
    bf16_t* AC = (bf16_t*)(p.ws + WS_YBUF) + (size_t)(d * 2 + 0) * MT * 512; bf16_t* HL = (bf16_t*)(p.ws + WS_YBUF) + (size_t)(d * 2 + 1) * MT * 512;
    LAS float* SA = (LAS float*)lds; LAS float* SB = SA + 16384;
    const bool lastw = d == 0 ? (wid == 7) : (wid == 0);
#pragma unroll
    for (int jb = 0; jb < 8; ++jb) { const int jj = jb * 16 + fr;
        float Aw = 1.f, hw = 0.f;
        f32x2_t wt[8];
#pragma unroll
        for (int w = 0; w < 8; ++w) wt[w] = *(const LAS f32x2_t*)(WT + (w * 128 + jj) * 2);
#pragma unroll
        for (int q = 0; q < 8; ++q) { const int w = d == 0 ? q : 7 - q; const bool use = d == 0 ? (w < wid) : (w > wid);
            const f32x2_t v = d == 0 ? wt[q] : wt[7 - q]; (void)w;
            if (use) { hw = v.x * hw + v.y; Aw *= v.x; } }
        const float PA = Aw * Aq[jb], Ph = Aq[jb] * hw + hq[jb];
#pragma unroll
        for (int r = 0; r < 4; ++r) { const int t = 16 * wid + 4 * fq + r, so = t * 128 + (jj ^ ((fq & 1) << 4));
            const float Ac = PA * Al[jb][r], hc = Al[jb][r] * Ph + hl[jb][r];
            SA[so] = Ac; SB[so] = hc;
            if (lastw && lastq && r == (d == 0 ? 3 : 0)) { float* AG = (float*)(p.ws + WS_AGG) + ((size_t)(d * NCHUNK + ck) * 512 + h * 128 + jj) * 2; AG[0] = Ac; AG[1] = hc; } }
    }
    __syncthreads(); ISTAMP(23);
#pragma unroll
    for (int q8 = 0; q8 < 8; ++q8) { const int idx = tid + 512 * q8, t = idx >> 5, c4 = (idx & 31) * 4, so = t * 128 + (c4 ^ (((t >> 2) & 1) << 4)); const size_t go = (size_t)(ck * 128 + t) * 512 + h * 128 + c4;
        const f32x4_t va = *(const LAS f32x4_t*)(SA + so), vh = *(const LAS f32x4_t*)(SB + so);
        u32x2_t wa, wh; wa.x = pk2bf(va.x, va.y); wa.y = pk2bf(va.z, va.w); wh.x = pk2bf(vh.x, vh.y); wh.y = pk2bf(vh.z, vh.w);
        *(u32x2_t*)(AC + go) = wa; *(u32x2_t*)(HL + go) = wh; }
    __syncthreads();
}

__device__ __forceinline__ void lru2_item(const Params& p, int ck, int h, LAS unsigned char* lds, int tid_in) {
    int tid = tid_in; asm volatile("" : "+v"(tid));
    const bf16_t* P = (const bf16_t*)(p.ws + WS_PBUF); bf16_t* H = (bf16_t*)(p.ws + WS_HBUF);
    LAS float* CR = (LAS float*)lds;
    const bf16_t* Yb = (const bf16_t*)(p.ws + WS_YBUF); const size_t AS = (size_t)MT * 512;
    u32x2_t ra0[8], rh0[8], ra1[8], rh1[8], rzg[8];
#pragma unroll
    for (int q8 = 0; q8 < 8; ++q8) { const int idx = tid + 512 * q8, t = idx >> 5, c4 = (idx & 31) * 4; const size_t row = (size_t)ck * 128 + t, go = row * 512 + h * 128 + c4;
        ra0[q8] = *(const u32x2_t*)(Yb + go); rh0[q8] = *(const u32x2_t*)(Yb + AS + go); ra1[q8] = *(const u32x2_t*)(Yb + 2 * AS + go); rh1[q8] = *(const u32x2_t*)(Yb + 3 * AS + go);
        rzg[q8] = *(const u32x2_t*)(P + row * INC + ZG_OFF + h * 128 + c4); }
    if (tid < 256) { const int d = tid >> 7, j = tid & 127; const float* AG = (const float*)(p.ws + WS_AGG) + (size_t)d * NCHUNK * 1024 + (h * 128 + j) * 2;
        f32x2_t ag[18];
        if (ck < 128) { const int b = ck >> 4, jc = ck & 15, cc0 = 128 + 2 * b;
            ag[0] = *(const f32x2_t*)(AG + (size_t)(d == 0 ? cc0 : cc0 + 1) * 1024); ag[1] = *(const f32x2_t*)(AG + (size_t)(d == 0 ? cc0 + 1 : cc0) * 1024);
#pragma unroll
            for (int q = 0; q < 16; ++q) { const int lq = d == 0 ? q : 15 - q; const bool valid = d == 0 ? (lq < jc) : (lq > jc);
                ag[2 + q] = valid ? *(const f32x2_t*)(AG + (size_t)(b * 16 + lq) * 1024) : (f32x2_t){1.f, 0.f}; } }
        else { const int jc = (ck - 128) & 1; const bool valid = d == 0 ? (jc == 1) : (jc == 0); const int qn = d == 0 ? ck - 1 : ck + 1;
            ag[0] = valid ? *(const f32x2_t*)(AG + (size_t)qn * 1024) : (f32x2_t){1.f, 0.f};
#pragma unroll
            for (int q = 1; q < 18; ++q) ag[q] = (f32x2_t){1.f, 0.f}; }
        float c = 0.f;
#pragma unroll
        for (int q = 0; q < 18; ++q) c = ag[q].x * c + ag[q].y;
        CR[tid] = c; }
    __syncthreads();
#pragma unroll
    for (int q8 = 0; q8 < 8; ++q8) { const int idx = tid + 512 * q8, t = idx >> 5, c4 = (idx & 31) * 4; const size_t row = (size_t)ck * 128 + t;
        const u32x2_t wa0 = ra0[q8], wh0 = rh0[q8], wa1 = ra1[q8], wh1 = rh1[q8];
        const f32x4_t a0 = {bflo(wa0.x), bfhi(wa0.x), bflo(wa0.y), bfhi(wa0.y)}, h0 = {bflo(wh0.x), bfhi(wh0.x), bflo(wh0.y), bfhi(wh0.y)};
        const f32x4_t a1 = {bflo(wa1.x), bfhi(wa1.x), bflo(wa1.y), bfhi(wa1.y)}, h1 = {bflo(wh1.x), bfhi(wh1.x), bflo(wh1.y), bfhi(wh1.y)};
        const f32x4_t c0 = *(const LAS f32x4_t*)(CR + c4), c1 = *(const LAS f32x4_t*)(CR + 128 + c4);
        const u32x2_t zg = rzg[q8];
        const f32x4_t hs = a0 * c0 + h0 + a1 * c1 + h1;
        u32x2_t o; o.x = pk2bf(hs.x * gelu_tanh(bflo(zg.x)), hs.y * gelu_tanh(bfhi(zg.x))); o.y = pk2bf(hs.z * gelu_tanh(bflo(zg.y)), hs.w * gelu_tanh(bfhi(zg.y)));
        *(u32x2_t*)(H + row * DM + 1536 + h * 128 + c4) = o; }
    __syncthreads();
}

typedef const __attribute__((address_space(4))) Params* KParams;
#define PH_BEGIN() KParams kp_ = (KParams)__builtin_amdgcn_kernarg_segment_ptr(); asm volatile("" : "+s"(kp_)); Params p; _Pragma("unroll") for (int i_ = 0; i_ < 19; ++i_) p.in[i_] = kp_->in[i_]; p.out = kp_->out; p.ws = kp_->ws; \
    int tid_o = threadIdx.x; asm volatile("" : "+v"(tid_o)); const int tid = tid_o, wid = __builtin_amdgcn_readfirstlane(tid >> 6), lane = tid & 63, gw = blockIdx.x * 8 + wid; \
    unsigned char* const ws = p.ws; (void)gw; (void)lane; (void)tid; (void)ws
__global__ void __launch_bounds__(512, 2) mega_fwd(Params p_arg) {
    extern __shared__ __attribute__((aligned(16))) unsigned char shm[];
    cg::grid_group grid = cg::this_grid();
    LAS unsigned char* lds = (LAS unsigned char*)shm;
    volatile LAS unsigned* bst = (volatile LAS unsigned*)(lds + 131072);
    if (threadIdx.x == 0) { bst[0] = 0u; bst[1] = 0u; }
    __syncthreads();
    (void)xcd_barrier_post((unsigned*)(p_arg.ws + WS_BAR), bst);
#define GSYNC() do { KParams kq_ = (KParams)__builtin_amdgcn_kernarg_segment_ptr(); asm volatile("" : "+s"(kq_)); XcdBarrier xb_; xb_.bar = (unsigned*)(kq_->ws + WS_BAR); { unsigned x_ = xb_xcc_id(); asm volatile("" : "+s"(x_)); xb_.x = x_; } \
        xb_.st = (volatile LAS unsigned*)((LAS unsigned char*)shm + 131072); xcd_barrier(xb_); } while (0)
    const int G = gridDim.x, NGW = G * 8;
#ifdef PROBE_MASK
    unsigned long long ts_ = wall_clock64(), tsel_ = 0ull;
#define STAMP(bit) do { const unsigned long long n_ = wall_clock64(); if ((PROBE_MASK) & (1u << (bit))) tsel_ += n_ - ts_; ts_ = n_; } while (0)
#else
#define STAMP(bit) do {} while (0)
#endif

#ifndef NO_P0
    { PH_BEGIN(); phase0(p, lds, tid, wid, lane); }
#endif
    if (p_arg.ws == nullptr) grid.sync();
    GSYNC(); STAMP(0);
#ifndef NO_ROWS
    { PH_BEGIN(); phaseA(p, gw, NGW, lane); }
#endif
    GSYNC(); STAMP(1);
#ifdef EXTRA_SYNCS
    for (int i_ = 0; i_ < EXTRA_SYNCS; ++i_) GSYNC();
#endif

#pragma unroll 1
    for (int l = 0; l < NLAYER; ++l) {
        const bool last = (l == NLAYER - 1);
        const int mrows = last ? ML : MT;
#ifndef NO_G1
        { PH_BEGIN(); pg8::StaticOrder S; S.init(MT, INC, G, blockIdx.x); pg8::EpiBf16 E{(bf16_t*)(ws + WS_PBUF), INC};
          pg8::gemm_phase<pg8::EpiBf16, pg8::StaticOrder, false>(lds, pg8::Gemm{(const bf16_t*)(ws + WS_HBUF), (const bf16_t*)(ws + WS_WIN + l * SZ_WIN), MT, INC, DM, DM}, S, E, nullptr); }
#endif
        GSYNC(); STAMP(2);
#ifndef NO_C
        { PH_BEGIN(); const int n_lru = NCHUNK * 8, n_mlp = (last ? 128 : NCHUNK) * 4;
          for (int it = blockIdx.x; it < n_lru + n_mlp; it += G) {
              if (it < n_lru) { lru1_item(p, l, it >> 3, (it >> 1) & 3, it & 1, lds, tid, wid, lane PROBE_PASS); STAMP(10); }
              else { const int r = it - n_lru; mlp_item(p, l, r >> 2, r & 3, lds, tid, wid, lane); STAMP(11); } }
          qk_rows(p, l, gw, NGW, lane); STAMP(12); }
#endif
        GSYNC(); STAMP(3);
#ifndef NO_D
        { PH_BEGIN(); const int n_att = 512 + (last ? 0 : 64), n_l2 = (last ? 128 : NCHUNK) * 4;
          bf16_t* HB = (bf16_t*)(ws + WS_HBUF); const bf16_t* PB = (const bf16_t*)(ws + WS_PBUF);
          for (int it = blockIdx.x; it < n_att + n_l2; it += G) {
              if (it < n_att) {
                  size_t qrow; int b, hq, seq;
                  if (it < 512) { b = it >> 6; hq = (it >> 3) & 7; const int qb = it & 7; qrow = (size_t)b * SEQ + qb * 256; seq = SKV; }
                  else { const int c = it - 512; b = c >> 3; hq = c & 7; qrow = (size_t)ML + b * CTXL; seq = CTXL; }
                  const size_t kvo = (size_t)(b * 2 + (hq >> 2)) * SKV * 128;
                  attn_dense_body<bf16>((const bf16*)(PB + qrow * INC + hq * 128), (const bf16*)((const bf16_t*)(ws + WS_KBUF) + kvo), (const bf16*)((const bf16_t*)(ws + WS_VBUF) + kvo),
                                        HB + qrow * DM + hq * 128, seq, (char*)shm, p.in[I_GQK] + l * 256, it < 512 ? (it & 7) * 256 : -1);
                  __syncthreads(); STAMP(13);
              } else {
#ifndef NO_L2
                  const int r = it - n_att; lru2_item(p, r >> 2, r & 3, lds, tid);
#endif
              } } }
#endif
        GSYNC(); STAMP(4);
#ifndef NO_G2
        { PH_BEGIN(); pg8::StaticOrder S; S.init(ML, DM, G, blockIdx.x); pg8::EpiBf16 E{(bf16_t*)(ws + WS_YBUF), DM};
          pg8::gemm_phase<pg8::EpiBf16, pg8::StaticOrder, false>(lds, pg8::Gemm{(const bf16_t*)(ws + WS_HBUF), (const bf16_t*)(ws + WS_WOUT + l * SZ_WOUT), ML, DM, DM, DM}, S, E, nullptr);
          if (!last) {
              pg8::SplitOrder S2; S2.init(MC, DM, 4, G, blockIdx.x); pg8::EpiBf16Split E2{(bf16_t*)(ws + WS_YPART), DM, (size_t)MC * DM};
              pg8::gemm_phase<pg8::EpiBf16Split, pg8::SplitOrder, false>(lds, pg8::Gemm{(const bf16_t*)(ws + WS_HBUF) + (size_t)ML * DM, (const bf16_t*)(ws + WS_WOUT + l * SZ_WOUT), MC, DM, DM / 4, DM}, S2, E2, nullptr); } }
#endif
        GSYNC(); STAMP(5);
#ifndef NO_ROWS
        { PH_BEGIN(); const float* gn = p.in[I_GNORM] + (size_t)l * 4 * DM; const float* ml = (const float*)(ws + WS_MOD) + (size_t)l * 9 * 6 * DM;
          if (l == 0) row_update<true, false>(p, mrows, ml, 2 * DM, gn + DM, true, gn + 2 * DM, ml, 3 * DM, 4 * DM, gw, NGW, lane);
          else row_update<false, false>(p, mrows, ml, 2 * DM, gn + DM, true, gn + 2 * DM, ml, 3 * DM, 4 * DM, gw, NGW, lane); }
#endif
        GSYNC(); STAMP(6);
#ifndef NO_G3
        { PH_BEGIN(); pg8::StaticOrder S; S.init(mrows, 2 * DFF, G, blockIdx.x); pg8::EpiSwiglu E{(bf16_t*)(ws + WS_PBUF), DFF};
          pg8::gemm_phase<pg8::EpiSwiglu, pg8::StaticOrder, false>(lds, pg8::Gemm{(const bf16_t*)(ws + WS_HBUF), (const bf16_t*)(ws + WS_WFI + l * SZ_WFI), mrows, 2 * DFF, DM, DM}, S, E, nullptr); }
#endif
        GSYNC(); STAMP(7);
#ifndef NO_G4
        { PH_BEGIN(); pg8::StaticOrder S; S.init(ML, DM, G, blockIdx.x); pg8::EpiBf16 E{(bf16_t*)(ws + WS_YBUF), DM};
          pg8::gemm_phase<pg8::EpiBf16, pg8::StaticOrder, false>(lds, pg8::Gemm{(const bf16_t*)(ws + WS_PBUF), (const bf16_t*)(ws + WS_WFO + l * SZ_WFO), ML, DM, DFF, DFF}, S, E, nullptr);
          if (!last) {
              pg8::SplitOrder S2; S2.init(MC, DM, 4, G, blockIdx.x); pg8::EpiBf16Split E2{(bf16_t*)(ws + WS_YPART), DM, (size_t)MC * DM};
              pg8::gemm_phase<pg8::EpiBf16Split, pg8::SplitOrder, false>(lds, pg8::Gemm{(const bf16_t*)(ws + WS_PBUF) + (size_t)ML * DFF, (const bf16_t*)(ws + WS_WFO + l * SZ_WFO), MC, DM, DFF / 4, DFF}, S2, E2, nullptr); } }
#endif
        GSYNC(); STAMP(8);
#ifndef NO_ROWS
        { PH_BEGIN(); const float* gn = p.in[I_GNORM] + (size_t)l * 4 * DM; const float* ml = (const float*)(ws + WS_MOD) + (size_t)l * 9 * 6 * DM;
          const float* gnn = p.in[I_GNORM] + (size_t)(last ? l : l + 1) * 4 * DM; const float* mln = (const float*)(ws + WS_MOD) + (size_t)(last ? l : l + 1) * 9 * 6 * DM;
          if (last) row_update<false, true>(p, mrows, ml, 5 * DM, gn + 3 * DM, false, gnn, mln, 0, DM, gw, NGW, lane);
          else { row_update<false, false>(p, mrows, ml, 5 * DM, gn + 3 * DM, true, gnn, mln, 0, DM, gw, NGW, lane);
                 convert_layer(p, l + 1, gw, NGW, PL, lds, wid, lane); } }
#endif
        if (!last) { GSYNC(); STAMP(9); }
    }
#ifdef PROBE_MASK
    GSYNC(); STAMP(9);
    if (blockIdx.x == 0) { const float t_us = (float)tsel_ * 0.01f; const float delta = 0.1f * sqrtf(t_us * (1.f / 5000.f));
        for (int i = threadIdx.x; i < 65536; i += 512) p_arg.out[i] += delta; }
#endif
}

extern "C" void kernel_launch(void* const* d_in, const int* in_sizes, int n_in, void* d_out, int out_size, void* d_ws, size_t ws_size, hipStream_t stream) {
    static int grid_blocks = 0;
    if (grid_blocks == 0) {
        if (n_in != 19 || out_size != ML * DM || ws_size < WS_END) { fprintf(stderr, "kernel_launch: unexpected shapes (n_in %d out %d ws %zu need %zu)\n", n_in, out_size, ws_size, (size_t)WS_END); grid_blocks = -1; return; }
        int dev = 0, cus = 0, per_cu = 0;
        hipGetDevice(&dev);
        hipDeviceGetAttribute(&cus, hipDeviceAttributeMultiprocessorCount, dev);
        if (hipFuncSetAttribute((const void*)mega_fwd, hipFuncAttributeMaxDynamicSharedMemorySize, LDS_BYTES) != hipSuccess) { fprintf(stderr, "kernel_launch: hipFuncSetAttribute failed\n"); grid_blocks = -1; return; }
        if (hipOccupancyMaxActiveBlocksPerMultiprocessor(&per_cu, (const void*)mega_fwd, 512, LDS_BYTES) != hipSuccess || per_cu < 1) { fprintf(stderr, "kernel_launch: occupancy query failed (%d)\n", per_cu); per_cu = 1; }
        (void)hipGetLastError();
        grid_blocks = cus * 1;
    }
    if (grid_blocks < 0) return;
    if (hipMemsetAsync((char*)d_ws + WS_BAR, 0, XCD_BAR_WORDS * 4, stream) != hipSuccess) { fprintf(stderr, "kernel_launch: memset failed\n"); return; }
    Params p{};
    for (int i = 0; i < 19; ++i) p.in[i] = (const float*)d_in[i];
    p.out = (float*)d_out; p.ws = (unsigned char*)d_ws;
    void* args[] = {&p};
    hipError_t e = hipLaunchCooperativeKernel((const void*)mega_fwd, dim3(grid_blocks), dim3(512), args, LDS_BYTES, stream);
    if (e != hipSuccess) fprintf(stderr, "cooperative launch failed: %s (grid %d)\n", hipGetErrorString(e), grid_blocks);
}
```

```cpp
#define ATT_QFUSE 1
#include <hip/hip_runtime.h>
#include <hip/hip_bf16.h>
#include <hip/hip_cooperative_groups.h>
#include <cstdio>
#include <cstdint>
namespace cg = cooperative_groups;

#define LAS __attribute__((address_space(3)))
typedef unsigned short bf16_t;
typedef float f32x4_t __attribute__((ext_vector_type(4)));
typedef float f32x2_t __attribute__((ext_vector_type(2)));
typedef unsigned u32x4_t __attribute__((ext_vector_type(4)));
typedef unsigned u32x2_t __attribute__((ext_vector_type(2)));

constexpr int DM = 2048, NB = 8, SEQ = 2048, CTXL = 256, NLAYER = 2;
constexpr int ML = NB * SEQ, MC = NB * CTXL, MT = ML + MC;
constexpr int INC = 3584, DFF = 5632, SKV = CTXL + SEQ;
constexpr int K_OFF = 1024, V_OFF = 1280, ZM_OFF = 1536, ZX_OFF = 2560, ZG_OFF = 3072;
constexpr int NCHUNK = MT / 128;
constexpr float EPS = 1e-6f;

constexpr size_t SZ_WIN = (size_t)INC * DM * 2, SZ_WOUT = (size_t)DM * DM * 2, SZ_WFI = (size_t)2 * DFF * DM * 2, SZ_WFO = (size_t)DM * DFF * 2;
constexpr size_t SZ_LRUW = (size_t)16 * 128 * 128 * 2, SZ_WSB = (size_t)4 * 128 * 128 * 2, SZ_MOD = (size_t)NLAYER * 9 * 6 * DM * 4;
constexpr size_t WS_WIN = 0;
constexpr size_t WS_WOUT = WS_WIN + NLAYER * SZ_WIN;
constexpr size_t WS_WFI = WS_WOUT + NLAYER * SZ_WOUT;
constexpr size_t WS_WFO = WS_WFI + NLAYER * SZ_WFI;
constexpr size_t WS_LRUW = WS_WFO + NLAYER * SZ_WFO;
constexpr size_t WS_WSB = WS_LRUW + NLAYER * SZ_LRUW;
constexpr size_t WS_MOD = WS_WSB + NLAYER * SZ_WSB;
constexpr size_t WS_HBUF = WS_MOD + SZ_MOD;
constexpr size_t WS_PBUF = WS_HBUF + (size_t)MT * DM * 2;
constexpr size_t WS_YBUF = WS_PBUF + (size_t)MT * DFF * 2;
constexpr size_t WS_YPART = WS_YBUF + (size_t)MT * DM * 2;
constexpr size_t WS_KBUF = WS_YBUF + (size_t)MT * DM * 4;
constexpr size_t WS_VBUF = WS_KBUF + (size_t)NB * 2 * SKV * 128 * 2;
constexpr size_t WS_XC = WS_VBUF + (size_t)NB * 2 * SKV * 128 * 2;
constexpr size_t WS_AGG = WS_XC + (size_t)MC * DM * 4;
constexpr size_t WS_BAR = WS_AGG + (size_t)2 * NCHUNK * 512 * 2 * 4;
constexpr size_t WS_XB = WS_BAR + 16384;
constexpr size_t WS_END = WS_XB + (size_t)MT * DM * 2;
constexpr int LDS_BYTES = 131072 + 64 + 8192;

__device__ __forceinline__ unsigned pk2bf(float lo, float hi) { unsigned r; asm volatile("v_cvt_pk_bf16_f32 %0, %1, %2" : "=v"(r) : "v"(lo), "v"(hi)); return r; }
__device__ __forceinline__ unsigned short f2bf(float f) { return (unsigned short)(pk2bf(f, 0.f) & 0xffffu); }
__device__ __forceinline__ float bf2f(unsigned short b) { return __uint_as_float(((unsigned)b) << 16); }
__device__ __forceinline__ float bflo(unsigned w) { return __uint_as_float(w << 16); }
__device__ __forceinline__ float bfhi(unsigned w) { return __uint_as_float(w & 0xffff0000u); }
__device__ __forceinline__ float sigmoid_f(float x) { return __builtin_amdgcn_rcpf(1.f + __expf(-x)); }
__device__ __forceinline__ float gelu_tanh(float x) { const float u = 1.5957691216057308f * (x + 0.044715f * x * x * x); return x * sigmoid_f(u); }
__device__ __forceinline__ float wave_sum(float v) {
#pragma unroll
    for (int o = 1; o < 64; o <<= 1) v += __shfl_xor(v, o);
    return v;
}
#define LDS_WAIT() asm volatile("s_waitcnt lgkmcnt(0)" ::: "memory")

namespace pg8 {
#define PG8_LAS __attribute__((address_space(3)))
typedef unsigned short bf16_t;
typedef short bf16x8 __attribute__((ext_vector_type(8)));
typedef float f32x4 __attribute__((ext_vector_type(4)));
typedef unsigned u32x4 __attribute__((ext_vector_type(4)));
constexpr int BM = 256, BK = 64, HALF = 128, HTB = HALF * BK * 2  , STAGE_BYTES = 8 * HTB, NXCD = 8, WGM = 8;

__host__ __device__ __forceinline__ int lds_byte(int r, int c) { const int st = (r >> 4) * 2 + (c >> 5), rr = r & 15, cc = c & 31, ob = rr * 64 + cc * 2; return st * 1024 + (ob ^ (((ob >> 9) & 1) << 5)); }
__host__ __device__ __forceinline__ void stage_rc(int b, int& R, int& C) { const int st = b / 1024, sb = b % 1024, swz = sb ^ (((sb >> 9) & 1) << 5); R = (st >> 1) * 16 + swz / 64; C = (st & 1) * 32 + (swz % 64) / 2; }
__host__ __device__ __forceinline__ int perm32(int rho) { const int n = rho >> 4, i = rho & 15; return 8 * (i >> 2) + 4 * n + (i & 3); }

struct Unit { int pm, pn, ks; };
struct Gemm { const bf16_t* A; const bf16_t* Bt; int M, N, K, ld; };

struct StaticOrder {
    int nM, nN, nwg, G, c;
    __host__ __device__ void init(int M, int N, int G_, int c_) { nM = M / BM; nN = N / BM; nwg = nM * nN; G = G_; c = c_; }
    __host__ __device__ bool next(int i, Unit& u) const {
        const long L = (long)i * G + c; if (L >= nwg) return false;
        int wgid = (int)L; { const int q = nwg / NXCD, r = nwg % NXCD, xcd = wgid % NXCD, off = wgid / NXCD; wgid = (xcd < r ? xcd * (q + 1) : r * (q + 1) + (xcd - r) * q) + off; }
        const int nig = WGM * nN, gid = wgid / nig, fm = gid * WGM, gsz = (nM - fm) < WGM ? (nM - fm) : WGM;
        u.pm = fm + ((wgid % nig) % gsz); u.pn = (wgid % nig) / gsz; u.ks = 0; return true;
    }
    __device__ __forceinline__ void a_ready(const Unit&) const {}
    __device__ __forceinline__ void done(const Unit&) const {}
};
struct SplitOrder {
    int nM, nN, NS, G, c;
    __host__ __device__ void init(int M, int N, int NS_, int G_, int c_) { nM = M / BM; nN = N / BM; NS = NS_; G = G_; c = c_; }
    __host__ __device__ bool next(int i, Unit& u) const {
        const long L = (long)i * G + c; if (L >= (long)nM * nN * NS) return false;
        const int ks = (int)(L % NS), tile = (int)(L / NS); u.pm = tile % nM; u.pn = tile / nM; u.ks = ks; return true;
    }
    __device__ __forceinline__ void a_ready(const Unit&) const {}
    __device__ __forceinline__ void done(const Unit&) const {}
};
__device__ __forceinline__ unsigned cvt_pk_bf16(float lo, float hi) { unsigned r; asm volatile("v_cvt_pk_bf16_f32 %0, %1, %2" : "=v"(r) : "v"(lo), "v"(hi)); return r; }
struct EpiF32 {
    static constexpr bool PERM = false, AFTER_DRAIN = false;
    float* C; int ldc;
    __device__ __forceinline__ void operator()(const f32x4 (&acc)[2][2][4][2], const Unit& u, int wr, int wc, int fr, int fq) const {
        const int row0 = u.pm * BM + wr * 64 + fr, col0 = u.pn * BM + wc * 32 + 4 * fq;
#pragma unroll
        for (int ai = 0; ai < 2; ++ai)
#pragma unroll
            for (int m = 0; m < 4; ++m) { float* rowp = C + (size_t)(row0 + ai * HALF + m * 16) * ldc + col0;
#pragma unroll
                for (int bj = 0; bj < 2; ++bj)
#pragma unroll
                    for (int n = 0; n < 2; ++n) *(f32x4*)(rowp + bj * HALF + n * 16) = acc[ai][bj][m][n]; }
    }
};
struct EpiBf16 {
    static constexpr bool PERM = true, AFTER_DRAIN = false;
    bf16_t* O; int ldc;
    __device__ __forceinline__ void operator()(const f32x4 (&acc)[2][2][4][2], const Unit& u, int wr, int wc, int fr, int fq) const {
        const int row0 = u.pm * BM + wr * 64 + fr, col0 = u.pn * BM + wc * 32 + 8 * fq;
#pragma unroll
        for (int ai = 0; ai < 2; ++ai)
#pragma unroll
            for (int m = 0; m < 4; ++m) { bf16_t* rowp = O + (size_t)(row0 + ai * HALF + m * 16) * ldc + col0;
#pragma unroll
                for (int bj = 0; bj < 2; ++bj) { const f32x4 v0 = acc[ai][bj][m][0], v1 = acc[ai][bj][m][1];
                    u32x4 w; w.x = cvt_pk_bf16(v0[0], v0[1]); w.y = cvt_pk_bf16(v0[2], v0[3]); w.z = cvt_pk_bf16(v1[0], v1[1]); w.w = cvt_pk_bf16(v1[2], v1[3]);
                    *(u32x4*)(rowp + bj * HALF) = w; } }
    }
};
struct EpiSwiglu {
    static constexpr bool PERM = true, AFTER_DRAIN = false;
    bf16_t* O; int ldc;
    __device__ __forceinline__ void operator()(const f32x4 (&acc)[2][2][4][2], const Unit& u, int wr, int wc, int fr, int fq) const {
        const int row0 = u.pm * BM + wr * 64 + fr, col0 = u.pn * HALF + wc * 32 + 8 * fq;
#pragma unroll
        for (int ai = 0; ai < 2; ++ai)
#pragma unroll
            for (int m = 0; m < 4; ++m) { bf16_t* rowp = O + (size_t)(row0 + ai * HALF + m * 16) * ldc + col0;
                float v[8];
#pragma unroll
                for (int n = 0; n < 2; ++n)
#pragma unroll
                    for (int j = 0; j < 4; ++j) { const float g = acc[ai][0][m][n][j], uu = acc[ai][1][m][n][j];
                        v[n * 4 + j] = g * __builtin_amdgcn_rcpf(1.f + __expf(-g)) * uu; }
                u32x4 w; w.x = cvt_pk_bf16(v[0], v[1]); w.y = cvt_pk_bf16(v[2], v[3]); w.z = cvt_pk_bf16(v[4], v[5]); w.w = cvt_pk_bf16(v[6], v[7]);
                *(u32x4*)rowp = w; }
    }
};
struct EpiF32Split {
    static constexpr bool PERM = false, AFTER_DRAIN = false;
    float* C; int ldc; size_t split_stride;
    __device__ __forceinline__ void operator()(const f32x4 (&acc)[2][2][4][2], const Unit& u, int wr, int wc, int fr, int fq) const {
        const int row0 = u.pm * BM + wr * 64 + fr, col0 = u.pn * BM + wc * 32 + 4 * fq; float* Cb = C + (size_t)u.ks * split_stride;
#pragma unroll
        for (int ai = 0; ai < 2; ++ai)
#pragma unroll
            for (int m = 0; m < 4; ++m) { float* rowp = Cb + (size_t)(row0 + ai * HALF + m * 16) * ldc + col0;
#pragma unroll
                for (int bj = 0; bj < 2; ++bj)
#pragma unroll
                    for (int n = 0; n < 2; ++n) *(f32x4*)(rowp + bj * HALF + n * 16) = acc[ai][bj][m][n]; }
    }
};
struct EpiBf16Split {
    static constexpr bool PERM = true, AFTER_DRAIN = false;
    bf16_t* O; int ldc; size_t split_stride;
    __device__ __forceinline__ void operator()(const f32x4 (&acc)[2][2][4][2], const Unit& u, int wr, int wc, int fr, int fq) const {
        const int row0 = u.pm * BM + wr * 64 + fr, col0 = u.pn * BM + wc * 32 + 8 * fq; bf16_t* Ob = O + (size_t)u.ks * split_stride;
#pragma unroll
        for (int ai = 0; ai < 2; ++ai)
#pragma unroll
            for (int m = 0; m < 4; ++m) { bf16_t* rowp = Ob + (size_t)(row0 + ai * HALF + m * 16) * ldc + col0;
#pragma unroll
                for (int bj = 0; bj < 2; ++bj) { const f32x4 v0 = acc[ai][bj][m][0], v1 = acc[ai][bj][m][1];
                    u32x4 w; w.x = cvt_pk_bf16(v0[0], v0[1]); w.y = cvt_pk_bf16(v0[2], v0[3]); w.z = cvt_pk_bf16(v1[0], v1[1]); w.w = cvt_pk_bf16(v1[2], v1[3]);
                    *(u32x4*)(rowp + bj * HALF) = w; } }
    }
};
template <class Epi, class Sched, bool STAMP = false>
__device__ __forceinline__ void gemm_phase(PG8_LAS unsigned char* lds, const Gemm g, const Sched& S, const Epi& E, unsigned long long* stamps) {
    int tid_o = threadIdx.x; asm volatile("" : "+v"(tid_o));
    const int tid = tid_o, wid = __builtin_amdgcn_readfirstlane(tid >> 6), lane = tid & 63, wr = wid >> 2, wc = wid & 3, fr = lane & 15, fq = lane >> 4;
    const int K = g.K, nt = K / BK, LD = g.ld;
    int ts_lo = 0, ts_hi = 0, nts = 0; const unsigned long long rt_entry = STAMP ? (unsigned long long)wall_clock64() : 0ull;
#define PG8_STAMP() do { if (STAMP && wid == 0 && nts < 64) { const unsigned long long _c = (unsigned long long)clock64(); \
        ts_lo = (lane == nts) ? (int)(unsigned)_c : ts_lo; ts_hi = (lane == nts) ? (int)(unsigned)(_c >> 32) : ts_hi; ++nts; } } while (0)
    PG8_STAMP();
    unsigned voffA[2], voffB[2];
#pragma unroll
    for (int i = 0; i < 2; ++i) { int R, C; stage_rc(tid * 16 + i * 8192, R, C); const int Rb = Epi::PERM ? ((R & ~31) + perm32(R & 31)) : R;
        voffA[i] = (unsigned)(R * LD + C) * 2u; voffB[i] = (unsigned)(Rb * LD + C) * 2u; }
    const size_t kstep = (size_t)(BK * 2);
    const size_t hstep = (size_t)HALF * LD * 2;
    const size_t tstep = 2 * hstep;
    const unsigned ldsw = (unsigned)wid * 1024u;
    const int aoff = lds_byte(wr * 64 + fr, fq * 8), boff = lds_byte(wc * 32 + fr, fq * 8);
#define PG8_SA(b, h) (((b) * 2 + (h)) * HTB)
#define PG8_SB(b, h) ((4 + (b) * 2 + (h)) * HTB)
#define PG8_STAGE(bufoff, gbase, voff) do { _Pragma("unroll") for (int _i = 0; _i < 2; ++_i) \
        __builtin_amdgcn_global_load_lds((const unsigned*)((const char*)(gbase) + (voff)[_i]), (PG8_LAS unsigned*)(lds + (bufoff) + ldsw + _i * 8192), 16, 0, 0); } while (0)
#define PG8_LDA(dst, b, h) do { _Pragma("unroll") for (int m = 0; m < 4; ++m) _Pragma("unroll") for (int k = 0; k < 2; ++k) dst[m][k] = *(const PG8_LAS bf16x8*)(lds + PG8_SA(b, h) + aoff + m * 2048 + k * 1024); } while (0)
#define PG8_LDB(dst, b, h) do { _Pragma("unroll") for (int n = 0; n < 2; ++n) _Pragma("unroll") for (int k = 0; k < 2; ++k) dst[n][k] = *(const PG8_LAS bf16x8*)(lds + PG8_SB(b, h) + boff + n * 2048 + k * 1024); } while (0)
#define PG8_MMA(ai, bj, At, Bt) do { __builtin_amdgcn_s_setprio(1); _Pragma("unroll") for (int m = 0; m < 4; ++m) _Pragma("unroll") for (int n = 0; n < 2; ++n) _Pragma("unroll") for (int k = 0; k < 2; ++k) \
        acc[ai][bj][m][n] = __builtin_amdgcn_mfma_f32_16x16x32_bf16(Bt[n][k], At[m][k], acc[ai][bj][m][n], 0, 0, 0); __builtin_amdgcn_s_setprio(0); } while (0)
#define PG8_WAIT_V(n) asm volatile("s_waitcnt vmcnt(" #n ")" ::: "memory")
#define PG8_WAIT_L(n) asm volatile("s_waitcnt lgkmcnt(" #n ")" ::: "memory")
#define PG8_BAR __builtin_amdgcn_s_barrier()
#define PG8_SCHED __builtin_amdgcn_sched_barrier(0)
    Unit cur, nxt; int ui = 0;
    if (!S.next(0, cur)) return;
    f32x4 acc[2][2][4][2];
#pragma unroll
    for (int a = 0; a < 2; ++a)
#pragma unroll
        for (int b = 0; b < 2; ++b)
#pragma unroll
            for (int m = 0; m < 4; ++m)
#pragma unroll
                for (int n = 0; n < 2; ++n) acc[a][b][m][n] = (f32x4){0.f, 0.f, 0.f, 0.f};
    bf16x8 At[4][2], B0[2][2], B1[2][2];
    const size_t ksb = (size_t)K * 2;
    const char* cA = (const char*)g.A + (size_t)cur.pm * tstep + (size_t)cur.ks * ksb; const char* cB = (const char*)g.Bt + (size_t)cur.pn * tstep + (size_t)cur.ks * ksb;
    S.a_ready(cur);
    PG8_STAGE(PG8_SB(0, 0), cB, voffB); PG8_STAGE(PG8_SA(0, 0), cA, voffA); PG8_STAGE(PG8_SB(0, 1), cB + hstep, voffB); PG8_STAGE(PG8_SA(0, 1), cA + hstep, voffA);
    if (wr == 1) PG8_BAR;
    PG8_WAIT_V(4); PG8_BAR;
    PG8_STAGE(PG8_SB(1, 0), cB + kstep, voffB); PG8_STAGE(PG8_SA(1, 0), cA + kstep, voffA); PG8_STAGE(PG8_SB(1, 1), cB + hstep + kstep, voffB);
    PG8_WAIT_V(6); PG8_BAR;
    PG8_STAMP();
    for (;;) {
        const bool has_next = S.next(ui + 1, nxt);
        const char* nA = has_next ? (const char*)g.A + (size_t)nxt.pm * tstep + (size_t)nxt.ks * ksb : cA; const char* nB = has_next ? (const char*)g.Bt + (size_t)nxt.pn * tstep + (size_t)nxt.ks * ksb : cB;
        for (int t = 0; t < nt; t += 2) {
            const bool last = (t == nt - 2);
            const char* a1 = cA + (size_t)(t + 1) * kstep;
            const char* a2 = last ? nA : cA + (size_t)(t + 2) * kstep; const char* b2 = last ? nB : cB + (size_t)(t + 2) * kstep;
            const char* a3 = a2 + kstep; const char* b3 = b2 + kstep;
            if (last && has_next) S.a_ready(nxt);
            PG8_LDB(B0, 0, 0); PG8_SCHED; PG8_LDA(At, 0, 0); PG8_STAGE(PG8_SA(1, 1), a1 + hstep, voffA);
            PG8_WAIT_L(8); PG8_BAR; PG8_WAIT_L(0); PG8_MMA(0, 0, At, B0); PG8_BAR; PG8_SCHED;
            PG8_LDB(B1, 0, 1); PG8_STAGE(PG8_SB(0, 0), b2, voffB);
            PG8_BAR; PG8_WAIT_L(0); PG8_MMA(0, 1, At, B1); PG8_BAR;
            PG8_LDA(At, 0, 1); PG8_STAGE(PG8_SA(0, 0), a2, voffA);
            PG8_BAR; PG8_WAIT_L(0); PG8_MMA(1, 0, At, B0); PG8_BAR; PG8_SCHED;
            PG8_STAGE(PG8_SB(0, 1), b2 + hstep, voffB);
            PG8_WAIT_V(6); PG8_BAR; PG8_MMA(1, 1, At, B1); PG8_BAR;
            PG8_LDB(B0, 1, 0); PG8_SCHED; PG8_LDA(At, 1, 0); PG8_STAGE(PG8_SA(0, 1), a2 + hstep, voffA);
            PG8_WAIT_L(8); PG8_BAR; PG8_WAIT_L(0); PG8_MMA(0, 0, At, B0); PG8_BAR; PG8_SCHED;
            PG8_LDB(B1, 1, 1); PG8_STAGE(PG8_SB(1, 0), b3, voffB);
            PG8_BAR; PG8_WAIT_L(0); PG8_MMA(0, 1, At, B1); PG8_BAR;
            PG8_LDA(At, 1, 1); PG8_STAGE(PG8_SA(1, 0), a3, voffA);
            PG8_BAR; PG8_WAIT_L(0); PG8_MMA(1, 0, At, B0); PG8_BAR; PG8_SCHED;
            PG8_STAGE(PG8_SB(1, 1), b3 + hstep, voffB);
            PG8_WAIT_V(6); PG8_BAR; PG8_MMA(1, 1, At, B1); PG8_BAR;
        }
        PG8_STAMP();
        if constexpr (!Epi::AFTER_DRAIN) { E(acc, cur, wr, wc, fr, fq); S.done(cur); }
        PG8_STAMP();
        if (!has_next) break;
#pragma unroll
        for (int a = 0; a < 2; ++a)
#pragma unroll
            for (int b = 0; b < 2; ++b)
#pragma unroll
                for (int m = 0; m < 4; ++m)
#pragma unroll
                    for (int n = 0; n < 2; ++n) acc[a][b][m][n] = (f32x4){0.f, 0.f, 0.f, 0.f};
        cur = nxt; cA = nA; cB = nB; ++ui;
    }
    PG8_WAIT_V(0);
    if (wr == 0) PG8_BAR;
    PG8_BAR;
    if constexpr (Epi::AFTER_DRAIN) { E.fused(acc, cur, wr, wc, fr, fq, lds, wid, lane); S.done(cur); }
    PG8_STAMP();
    if (STAMP && wid == 0) { stamps[lane] = lane < nts ? (((unsigned long long)(unsigned)ts_hi << 32) | (unsigned)ts_lo) : 0ull;
        if (lane == 62) stamps[62] = rt_entry; if (lane == 63) stamps[63] = (unsigned long long)wall_clock64(); }
#undef PG8_STAMP
#undef PG8_SA
#undef PG8_SB
#undef PG8_STAGE
#undef PG8_LDA
#undef PG8_LDB
#undef PG8_MMA
#undef PG8_WAIT_V
#undef PG8_WAIT_L
#undef PG8_BAR
#undef PG8_SCHED
}
}

using bf16 = __hip_bfloat16;
constexpr int   D = 128, NW = 8, QBLK = 32, KVBLK = 64;
constexpr float SCALE = 0.088388347648318440f;
constexpr float THR = 8.f;
#ifndef ATT_SDEPTH
#define ATT_SDEPTH 1
#endif
constexpr int SDEPTH = ATT_SDEPTH;
constexpr int LDQ = INC, LDK = 128, LDO = DM;
constexpr size_t SHM_V = KVBLK * D * 2, SHM_K = KVBLK * D * 2, SHM_ATTN = 2 * SHM_V + 2 * SHM_K + NW * 64 * 4;
using bf16x8 = __attribute__((ext_vector_type(8))) short;
using s16x4  = __attribute__((ext_vector_type(4))) short;
using f32x16 = __attribute__((ext_vector_type(16))) float;
using f32x8  = __attribute__((ext_vector_type(8))) float;
using u32x4  = __attribute__((ext_vector_type(4))) unsigned;
#define KSWZ(row, colB) ((row) * 256 + ((colB) ^ (((row) & 7) << 4)))
#define SBAR() __builtin_amdgcn_sched_barrier(0)
__device__ __forceinline__ int crow(int r, int hi) { return (r & 3) + 8 * (r >> 2) + 4 * hi; }
__device__ __forceinline__ unsigned cvtpk(float lo, float hi) {
  unsigned r; asm volatile("v_cvt_pk_bf16_f32 %0, %1, %2" : "=v"(r) : "v"(lo), "v"(hi)); return r;
}
template <typename TIn> struct Stage;
template <> struct Stage<bf16>  { using T = bf16x8;
  __device__ static __forceinline__ T ld8(const bf16* p) { return *reinterpret_cast<const bf16x8*>(p); }
  __device__ static __forceinline__ bf16x8 tobf(T x) { return x; } };
template <> struct Stage<float> { using T = f32x8;
  __device__ static __forceinline__ T ld8(const float* p) { return *reinterpret_cast<const f32x8*>(p); }
  __device__ static __forceinline__ bf16x8 tobf(T x) {
    u32x4 w = {cvtpk(x[0], x[1]), cvtpk(x[2], x[3]), cvtpk(x[4], x[5]), cvtpk(x[6], x[7])}; return *reinterpret_cast<bf16x8*>(&w); } };

__device__ __forceinline__ void partialSM(f32x16& p0, f32x16& p1, float& m_reg, float& mn, float& alpha) {
  constexpr float C = SCALE * 1.4426950408889634f;
  float pmax = p0[0]; for (int r = 1; r < 16; ++r) pmax = fmaxf(pmax, p0[r]); for (int r = 0; r < 16; ++r) pmax = fmaxf(pmax, p1[r]);
  { auto rr = __builtin_amdgcn_permlane32_swap(__float_as_uint(pmax), __float_as_uint(pmax), false, false);
    pmax = fmaxf(__uint_as_float(rr[0]), __uint_as_float(rr[1])); }
  if (__builtin_expect(__all(pmax - m_reg <= THR / SCALE), 1)) { mn = m_reg; alpha = 1.f; }
  else { mn = fmaxf(m_reg, pmax); alpha = __builtin_amdgcn_exp2f((m_reg - mn) * C); m_reg = mn; }
  float mnC = -mn * C;
  for (int r = 0; r < 16; ++r) p0[r] = fmaf(p0[r], C, mnC); for (int r = 0; r < 16; ++r) p1[r] = fmaf(p1[r], C, mnC);
  for (int r = 0; r < 16; ++r) p0[r] = __builtin_amdgcn_exp2f(p0[r]);
}
__device__ __forceinline__ void finishSM(f32x16& p0, f32x16& p1, float alpha, float& l_reg, bf16x8& pa0, bf16x8& pa1, bf16x8& pa2, bf16x8& pa3) {
  for (int r = 0; r < 16; ++r) p1[r] = __builtin_amdgcn_exp2f(p1[r]);
  float ps = 0; for (int r = 0; r < 16; ++r) ps += p0[r]; for (int r = 0; r < 16; ++r) ps += p1[r];
  { auto rr = __builtin_amdgcn_permlane32_swap(__float_as_uint(ps), __float_as_uint(ps), false, false);
    ps = __uint_as_float(rr[0]) + __uint_as_float(rr[1]); }
  l_reg = l_reg * alpha + ps;
#define PK4(P, BASE, OUT) do { unsigned a0 = cvtpk(P[BASE + 0], P[BASE + 1]), a1 = cvtpk(P[BASE + 2], P[BASE + 3]);   \
    unsigned b0 = cvtpk(P[BASE + 4], P[BASE + 5]), b1 = cvtpk(P[BASE + 6], P[BASE + 7]);                              \
    auto r0 = __builtin_amdgcn_permlane32_swap(a0, b0, false, false); auto r1 = __builtin_amdgcn_permlane32_swap(a1, b1, false, false); \
    u32x4 w = {r0[0], r1[0], r0[1], r1[1]}; OUT = *reinterpret_cast<bf16x8*>(&w); } while (0)
  PK4(p0, 0, pa0); PK4(p0, 8, pa1); PK4(p1, 0, pa2); PK4(p1, 8, pa3);
#undef PK4
}
__device__ __forceinline__ void qkt(f32x16& p0, f32x16& p1, const bf16* Ks, const bf16x8* qr, int r32, int hi) {
  p0 = f32x16{}; p1 = f32x16{};
  for (int d0 = 0; d0 < 8; ++d0) { int cb = (d0 * 16 + hi * 8) * 2;
    bf16x8 b0 = *reinterpret_cast<const bf16x8*>((const char*)Ks + KSWZ(r32, cb));
    bf16x8 b1 = *reinterpret_cast<const bf16x8*>((const char*)Ks + KSWZ(32 + r32, cb));
    p0 = __builtin_amdgcn_mfma_f32_32x32x16_bf16(b0, qr[d0], p0, 0, 0, 0);
    p1 = __builtin_amdgcn_mfma_f32_32x32x16_bf16(b1, qr[d0], p1, 0, 0, 0); }
}
__device__ __forceinline__ int v_st(int k, int c) { const int kk = (k & ~0xC) | ((k & 4) << 1) | ((k & 8) >> 1); return ((kk >> 3) * 4 + (c >> 5)) * 512 + ((kk & 7) * 32 + (c & 31)) * 2; }
__device__ __forceinline__ int v_rd_base(int lane) { return ((lane & 3) << 3) | (((lane >> 2) & 3) << 6) | (((lane >> 4) & 1) << 5) | (((lane >> 5) & 1) << 8); }
constexpr int v_rd_off(int d0, int ks, int half) { return d0 * 512 + ks * 4096 + half * 2048; }
template <int OFF> __device__ __forceinline__ s16x4 tr_read(int vb) {
  s16x4 r; asm volatile("ds_read_b64_tr_b16 %0, %1 offset:%2" : "=&v"(r) : "v"(vb), "i"(OFF) : "memory"); return r;
}
template <int D0> __device__ __forceinline__ void pv_one(f32x16& od, int vb, bf16x8 pa0, bf16x8 pa1, bf16x8 pa2, bf16x8 pa3) {
  const s16x4 l0 = tr_read<v_rd_off(D0, 0, 0)>(vb), h0 = tr_read<v_rd_off(D0, 0, 1)>(vb), l1 = tr_read<v_rd_off(D0, 1, 0)>(vb), h1 = tr_read<v_rd_off(D0, 1, 1)>(vb);
  const s16x4 l2 = tr_read<v_rd_off(D0, 2, 0)>(vb), h2 = tr_read<v_rd_off(D0, 2, 1)>(vb), l3 = tr_read<v_rd_off(D0, 3, 0)>(vb), h3 = tr_read<v_rd_off(D0, 3, 1)>(vb);
  asm volatile("s_waitcnt lgkmcnt(0)" ::: "memory"); SBAR();
#define PK(L, H) (bf16x8){L[0], L[1], L[2], L[3], H[0], H[1], H[2], H[3]}
  od = __builtin_amdgcn_mfma_f32_32x32x16_bf16(pa0, PK(l0, h0), od, 0, 0, 0);
  od = __builtin_amdgcn_mfma_f32_32x32x16_bf16(pa1, PK(l1, h1), od, 0, 0, 0);
  od = __builtin_amdgcn_mfma_f32_32x32x16_bf16(pa2, PK(l2, h2), od, 0, 0, 0);
  od = __builtin_amdgcn_mfma_f32_32x32x16_bf16(pa3, PK(l3, h3), od, 0, 0, 0);
#undef PK
}
__device__ __forceinline__ void pv_d0(f32x16* o, int vb, bf16x8 pa0, bf16x8 pa1, bf16x8 pa2, bf16x8 pa3) {
  pv_one<0>(o[0], vb, pa0, pa1, pa2, pa3); pv_one<1>(o[1], vb, pa0, pa1, pa2, pa3); pv_one<2>(o[2], vb, pa0, pa1, pa2, pa3); pv_one<3>(o[3], vb, pa0, pa1, pa2, pa3);
}

template <typename TQ>
__device__ __forceinline__ void attn_dense_body(const TQ* __restrict__ Qb, const bf16* __restrict__ Kh, const bf16* __restrict__ Vh,
                                                unsigned short* __restrict__ Ob, int seq, char* lds, const float* __restrict__ gq, int tok0) {
  using St = Stage<bf16>; using SQ = Stage<TQ>;
  int tid_o = threadIdx.x; asm volatile("" : "+v"(tid_o));
  const int tid = tid_o, wid = tid >> 6, lane = tid & 63, r32 = lane & 31, hi = lane >> 5;
  bf16* V_lds = (bf16*)lds; bf16* K_lds = (bf16*)(lds + 2 * SHM_V);
  float* ws = (float*)(lds + 2 * SHM_V + 2 * SHM_K) + wid * 64; float* li_l = ws; float* al_l = ws + 32;
  float m_reg = -1e30f, l_reg = 0; f32x16 o[4] = {}; bf16x8 qr[8];
  const TQ* Qw = Qb + (long)(wid * QBLK + r32) * LDQ + hi * 8;
#ifdef ATT_QFUSE
  { float xq[8][8];
#pragma unroll
    for (int d0 = 0; d0 < 8; ++d0) { const u32x4 w = *reinterpret_cast<const u32x4*>(Qw + d0 * 16);
      xq[d0][0] = __uint_as_float(w[0] << 16); xq[d0][1] = __uint_as_float(w[0] & 0xffff0000u); xq[d0][2] = __uint_as_float(w[1] << 16); xq[d0][3] = __uint_as_float(w[1] & 0xffff0000u);
      xq[d0][4] = __uint_as_float(w[2] << 16); xq[d0][5] = __uint_as_float(w[2] & 0xffff0000u); xq[d0][6] = __uint_as_float(w[3] << 16); xq[d0][7] = __uint_as_float(w[3] & 0xffff0000u); }
    float ss = 0.f;
#pragma unroll
    for (int d0 = 0; d0 < 8; ++d0)
#pragma unroll
      for (int e = 0; e < 8; ++e) ss += xq[d0][e] * xq[d0][e];
    ss += __shfl_xor(ss, 32);
    const float rs = rsqrtf(ss * (1.f / 128.f) + 1e-6f);
#pragma unroll
    for (int d0 = 0; d0 < 8; ++d0) { const float* gp = gq + d0 * 16 + hi * 8;
#pragma unroll
      for (int e = 0; e < 8; ++e) xq[d0][e] *= rs * gp[e]; }
    if (tok0 >= 0) { const int n = tok0 + wid * QBLK + r32;
#pragma unroll
      for (int a = 0; a < 2; ++a) { const float pos = (float)(a == 0 ? (n >> 6) : (n & 63));
#pragma unroll
        for (int dd = 0; dd < 2; ++dd)
#pragma unroll
          for (int e = 0; e < 8; ++e) { const int i = dd * 16 + hi * 8 + e;
            const float ang = pos * exp2f(-(float)(2 * i) * (13.287712379549449f / 64.f)); const float kf = rintf(ang * 0.15915494309189535f);
            float rr = fmaf(-kf, 6.2831854820251465f, ang); rr = fmaf(-kf, -1.7484555e-7f, rr); const float cs = __cosf(rr), sn = __sinf(rr);
            const float y0 = xq[a * 4 + dd][e], y1 = xq[a * 4 + 2 + dd][e];
            xq[a * 4 + dd][e] = y0 * cs - y1 * sn; xq[a * 4 + 2 + dd][e] = y1 * cs + y0 * sn; } } }
#pragma unroll
    for (int d0 = 0; d0 < 8; ++d0) { u32x4 w = {cvtpk(xq[d0][0], xq[d0][1]), cvtpk(xq[d0][2], xq[d0][3]), cvtpk(xq[d0][4], xq[d0][5]), cvtpk(xq[d0][6], xq[d0][7])}; qr[d0] = *reinterpret_cast<bf16x8*>(&w); } }
#else
  (void)gq; (void)tok0;
#pragma unroll
  for (int d0 = 0; d0 < 8; ++d0) qr[d0] = SQ::tobf(SQ::ld8(Qw + d0 * 16));
#endif
  const int sr = tid >> 4, sc = (tid & 15) * 8, vst0 = v_st(sr, sc), vst1 = v_st(32 + sr, sc);
  const int vb0 = (int)(uintptr_t)V_lds + v_rd_base(lane);
  struct { typename St::T vs0, vs1, ks0, ks1; } sr_[SDEPTH];
#define SLOAD(i, k0) do { sr_[i].vs0 = St::ld8(&Vh[(long)((k0) + sr) * LDK + sc]); sr_[i].vs1 = St::ld8(&Vh[(long)((k0) + 32 + sr) * LDK + sc]); \
    sr_[i].ks0 = St::ld8(&Kh[(long)((k0) + sr) * LDK + sc]); sr_[i].ks1 = St::ld8(&Kh[(long)((k0) + 32 + sr) * LDK + sc]); } while (0)
#define SWRITE(b, i) do { *(bf16x8*)((char*)V_lds + (b) * SHM_V + vst0) = St::tobf(sr_[i].vs0);          \
    *(bf16x8*)((char*)V_lds + (b) * SHM_V + vst1) = St::tobf(sr_[i].vs1); int kc = sc * 2;               \
    *(bf16x8*)((char*)K_lds + (b) * SHM_K + KSWZ(sr, kc)) = St::tobf(sr_[i].ks0);                       \
    *(bf16x8*)((char*)K_lds + (b) * SHM_K + KSWZ(32 + sr, kc)) = St::tobf(sr_[i].ks1); } while (0)
#define SWAIT() do { if constexpr (SDEPTH == 2) asm volatile("s_waitcnt vmcnt(4)" ::: "memory"); else asm volatile("s_waitcnt vmcnt(0)" ::: "memory"); } while (0)
#define RESC(a) do { if (__any((a) < 1.f)) { if (hi == 0) al_l[r32] = (a); asm volatile("s_waitcnt lgkmcnt(0)" ::: "memory"); \
    for (int d = 0; d < 4; ++d) for (int r = 0; r < 16; ++r) o[d][r] *= al_l[crow(r, hi)]; } } while (0)
  f32x16 pA0, pA1, pB0, pB1; float mnA, mnB, alA, alB; bf16x8 pa0, pa1, pa2, pa3; const int NT = seq / KVBLK;
  constexpr int SE = 0, SO = SDEPTH - 1;
  SLOAD(SE, 0); asm volatile("s_waitcnt vmcnt(0)" ::: "memory"); SWRITE(0, SE); __syncthreads();
  qkt(pA0, pA1, K_lds, qr, r32, hi); partialSM(pA0, pA1, m_reg, mnA, alA);
  SLOAD(SO, KVBLK); if constexpr (SDEPTH == 2) { if (2 < NT) SLOAD(SE, 2 * KVBLK); }
  SWAIT(); SWRITE(1, SO); __syncthreads();
  for (int j = 1; j + 1 < NT; j += 2) {
    SBAR(); qkt(pB0, pB1, (bf16*)((char*)K_lds + SHM_K), qr, r32, hi);
    finishSM(pA0, pA1, alA, l_reg, pa0, pa1, pa2, pa3); SBAR();
    SLOAD(SO, (j + SDEPTH) * KVBLK); SBAR();
    pv_d0(o, vb0, pa0, pa1, pa2, pa3); partialSM(pB0, pB1, m_reg, mnB, alB);
    __syncthreads(); SWAIT(); SWRITE(0, SE);
    RESC(alB); __syncthreads();
    SBAR(); qkt(pA0, pA1, K_lds, qr, r32, hi);
    finishSM(pB0, pB1, alB, l_reg, pa0, pa1, pa2, pa3); SBAR();
    if (SDEPTH == 1 || j + 3 < NT) SLOAD(SE, (j + 1 + SDEPTH) * KVBLK); SBAR();
    pv_d0(o, vb0 + (int)SHM_V, pa0, pa1, pa2, pa3); partialSM(pA0, pA1, m_reg, mnA, alA);
    __syncthreads(); SWAIT(); SWRITE(1, SO);
    RESC(alA); __syncthreads();
  }
  SBAR(); qkt(pB0, pB1, (bf16*)((char*)K_lds + SHM_K), qr, r32, hi);
  finishSM(pA0, pA1, alA, l_reg, pa0, pa1, pa2, pa3); SBAR();
  pv_d0(o, vb0, pa0, pa1, pa2, pa3); partialSM(pB0, pB1, m_reg, mnB, alB);
  __syncthreads(); RESC(alB);
  finishSM(pB0, pB1, alB, l_reg, pa0, pa1, pa2, pa3); SBAR();
  pv_d0(o, vb0 + (int)SHM_V, pa0, pa1, pa2, pa3);
  if (hi == 0) li_l[r32] = l_reg; asm volatile("s_waitcnt lgkmcnt(0)" ::: "memory");
  float rli[16];
#pragma unroll
  for (int r = 0; r < 16; ++r) rli[r] = __builtin_amdgcn_rcpf(li_l[crow(r, hi)]);
  unsigned short* Ow = Ob + (long)(wid * QBLK) * LDO;
#pragma unroll
  for (int r = 0; r < 16; ++r) { int orow = crow(r, hi);
    for (int d0 = 0; d0 < 4; ++d0) Ow[(long)orow * LDO + d0 * 32 + r32] = f2bf(o[d0][r] * rli[r]); }
#undef SLOAD
#undef SWRITE
#undef SWAIT
#undef RESC
}

#define XB_TMO      128
#define XB_XCNT(j)  (256  + 64 * (j))
#define XB_XSUB(j)  (1280 + 64 * (j))
#define XB_XGEN(j)  (2304 + 64 * (j))
#define XB_TOP      3328
#define XB_TOPGEN   3392
#define XCD_BAR_WORDS 3456
#define XB_SPIN_CAP (1u << 18)

__device__ __forceinline__ unsigned xb_ld(unsigned* p)              { return __hip_atomic_load(p, __ATOMIC_RELAXED, __HIP_MEMORY_SCOPE_AGENT); }
__device__ __forceinline__ unsigned xb_add(unsigned* p, unsigned v) { return __hip_atomic_fetch_add(p, v, __ATOMIC_RELAXED, __HIP_MEMORY_SCOPE_AGENT); }
__device__ __forceinline__ unsigned xb_xcc_id() { return (unsigned)__builtin_amdgcn_s_getreg((3 << 11) | 20) & 0xFu; }
#define XB_SPIN(cond, bar) do { unsigned _sp = 0; while (cond) { __builtin_amdgcn_s_sleep(1); \
    if ((++_sp & 255u) == 0u) { if (xb_ld(&(bar)[XB_TMO])) break; if (_sp > XB_SPIN_CAP) { atomicAdd(&(bar)[XB_TMO], 1u); break; } } } } while (0)

struct XcdBarrier {
    unsigned* bar; unsigned x;
    volatile LAS unsigned* st;
};

__device__ __forceinline__ XcdBarrier xcd_barrier_post(unsigned* bar, volatile LAS unsigned* st) {
    XcdBarrier b; b.bar = bar; b.x = xb_xcc_id(); b.st = st;
    if (threadIdx.x == 0) (void)xb_add(&bar[XB_XCNT(b.x)], 1u);
    return b;
}
__device__ __forceinline__ void xcd_barrier_complete(unsigned* bar, unsigned x, unsigned& nloc, unsigned& nx) {
    const unsigned G = gridDim.x * gridDim.y * gridDim.z;
    unsigned sum, cnt, mine, sp = 0u;
    for (;;) {
        sum = 0u; cnt = 0u; mine = 0u;
#pragma unroll
        for (unsigned j = 0; j < 16; ++j) { const unsigned c = xb_ld(&bar[XB_XCNT(j)]); sum += c; cnt += (c > 0u) ? 1u : 0u; mine = (j == x) ? c : mine; }
        if (sum == G) break;
        __builtin_amdgcn_s_sleep(1);
        if ((++sp & 255u) == 0u) { if (xb_ld(&bar[XB_TMO])) break; if (sp > XB_SPIN_CAP) { atomicAdd(&bar[XB_TMO], 1u); break; } }
    }
    nloc = mine > 0u ? mine : 1u; nx = cnt > 0u ? cnt : 1u;
}

__device__ __forceinline__ void xcd_barrier(const XcdBarrier& b) {
    asm volatile("s_waitcnt vmcnt(0)" ::: "memory");
    __syncthreads();
    if (threadIdx.x == 0) {
        unsigned* bar = b.bar;
        __builtin_amdgcn_s_waitcnt(0);
        unsigned nloc = b.st[0], nx = b.st[1];
        if (nloc == 0u) { xcd_barrier_complete(bar, b.x, nloc, nx); b.st[0] = nloc; b.st[1] = nx; }
        const unsigned old = xb_add(&bar[XB_XSUB(b.x)], 1u);
        const unsigned gen = old / nloc;
        if (old + 1u == (gen + 1u) * nloc) {
            __builtin_amdgcn_fence(__ATOMIC_RELEASE, "agent");
            asm volatile("s_waitcnt vmcnt(0)" ::: "memory");
            const unsigned og = xb_add(&bar[XB_TOP], 1u);
            const unsigned tg = og / nx;
            if (og + 1u == (tg + 1u) * nx) xb_add(&bar[XB_TOPGEN], 1u);
            else XB_SPIN(xb_ld(&bar[XB_TOPGEN]) == tg, bar);
            __builtin_amdgcn_fence(__ATOMIC_ACQUIRE, "agent");
            xb_add(&bar[XB_XGEN(b.x)], 1u);
            asm volatile("s_waitcnt vmcnt(0)" ::: "memory");
        } else {
            XB_SPIN(xb_ld(&bar[XB_XGEN(b.x)]) == gen, bar);
            __builtin_amdgcn_fence(__ATOMIC_ACQUIRE, "agent");
            asm volatile("s_waitcnt vmcnt(0)" ::: "memory");
        }
    }
    __syncthreads();
}

typedef short bf16x8_t __attribute__((ext_vector_type(8)));
struct Params { const float* in[19]; float* out; unsigned char* ws; };
enum { I_X = 0, I_C, I_CTX, I_CCTX, I_WMOD, I_BMOD, I_GNORM, I_WIN, I_GQK, I_WS, I_BS, I_CONVW, I_CONVB, I_LRUW, I_LRUB, I_LRULAM, I_WOUT, I_WFI, I_WFO };

__device__ __forceinline__ void transpose_item(const float* __restrict__ W, int ldw, bf16_t* __restrict__ dst, int ldk, LAS float* scr, int lane) {
#pragma unroll 8
    for (int i = 0; i < 32; ++i) { const int kk = 2 * i + (lane >> 5); scr[kk * 33 + (lane & 31)] = __builtin_nontemporal_load(W + (size_t)kk * ldw + (lane & 31)); }
    LDS_WAIT();
    const int c = lane & 7;
#pragma unroll
    for (int j = 0; j < 4; ++j) { const int n = (lane >> 3) + 8 * j; const LAS float* s = scr + (8 * c) * 33 + n;
        u32x4_t o; o.x = pk2bf(s[0 * 33], s[1 * 33]); o.y = pk2bf(s[2 * 33], s[3 * 33]); o.z = pk2bf(s[4 * 33], s[5 * 33]); o.w = pk2bf(s[6 * 33], s[7 * 33]);
        *(u32x4_t*)(dst + (size_t)n * ldk + 8 * c) = o; }
    LDS_WAIT();
}

__device__ __forceinline__ void mod_item(int it, const Params& p, LAS float* lds, int tid_in, int wid, int lane_in) {
    int tid = tid_in; asm volatile("" : "+v"(tid)); const int lane = tid & 63; (void)lane_in;
    const int l = it / 96, cgp = it % 96;
    const float* cv = p.in[I_C]; const float* cc = p.in[I_CCTX];
    for (int e = tid; e < 9 * DM; e += 512) { const int r = e >> 11, k = e & (DM - 1); const float v = r < 8 ? cv[r * DM + k] : cc[k]; lds[k * 12 + r] = v * sigmoid_f(v); }
    __syncthreads();
    const float* W = p.in[I_WMOD] + (size_t)l * DM * (6 * DM) + cgp * 128 + lane * 2;
    float acc[9][2];
#pragma unroll
    for (int r = 0; r < 9; ++r) { acc[r][0] = 0.f; acc[r][1] = 0.f; }
    const int kb = wid * 256;
#pragma unroll 16
    for (int k = 0; k < 256; ++k) {
        const f32x2_t w = __builtin_nontemporal_load((const f32x2_t*)(W + (size_t)(kb + k) * (6 * DM)));
        const LAS float* a = lds + (kb + k) * 12;
        const f32x4_t a0 = *(const LAS f32x4_t*)a, a1 = *(const LAS f32x4_t*)(a + 4); const float a8 = a[8];
        acc[0][0] += a0.x * w.x; acc[0][1] += a0.x * w.y; acc[1][0] += a0.y * w.x; acc[1][1] += a0.y * w.y;
        acc[2][0] += a0.z * w.x; acc[2][1] += a0.z * w.y; acc[3][0] += a0.w * w.x; acc[3][1] += a0.w * w.y;
        acc[4][0] += a1.x * w.x; acc[4][1] += a1.x * w.y; acc[5][0] += a1.y * w.x; acc[5][1] += a1.y * w.y;
        acc[6][0] += a1.z * w.x; acc[6][1] += a1.z * w.y; acc[7][0] += a1.w * w.x; acc[7][1] += a1.w * w.y;
        acc[8][0] += a8 * w.x; acc[8][1] += a8 * w.y;
    }
    __syncthreads();
#pragma unroll
    for (int r = 0; r < 9; ++r) { lds[(wid * 18 + r * 2 + 0) * 64 + lane] = acc[r][0]; lds[(wid * 18 + r * 2 + 1) * 64 + lane] = acc[r][1]; }
    __syncthreads();
    float* MOD = (float*)(p.ws + WS_MOD);
    for (int o = tid; o < 9 * 128; o += 512) { const int r = o >> 7, col = o & 127, q = r * 2 + (col & 1), ls = col >> 1;
        float s = p.in[I_BMOD][l * (6 * DM) + cgp * 128 + col];
#pragma unroll
        for (int w = 0; w < 8; ++w) s += lds[(w * 18 + q) * 64 + ls];
        MOD[(size_t)(l * 9 + r) * (6 * DM) + cgp * 128 + col] = s; }
    __syncthreads();
}

__device__ __forceinline__ void phase0(const Params& p, LAS unsigned char* lds, int tid, int wid, int lane) {
    for (int it = blockIdx.x; it < 192; it += gridDim.x) mod_item(it, p, (LAS float*)lds, tid, wid, lane);
    LAS float* scr = (LAS float*)lds + wid * (64 * 33);
    const int gw = blockIdx.x * 8 + wid, NGW = gridDim.x * 8;
    constexpr int NI_WIN = 32 * 112, NI_WOUT = 32 * 64, NI_WFI = 32 * 352, NI_WFO = 88 * 64, NI_LRU = 128, PL = NI_WIN + NI_WOUT + NI_WFI + NI_WFO + NI_LRU;
    int it0 = gw, itstep = NGW, itend = NLAYER * PL;
    if ((int)gridDim.x > 192) { const int n1 = min(((int)gridDim.x - 192) * 8 * 32, NLAYER * PL);
        if ((int)blockIdx.x >= 192) { it0 = ((int)blockIdx.x - 192) * 8 + wid; itstep = ((int)gridDim.x - 192) * 8; itend = n1; }
        else { it0 = n1 + gw; itstep = 192 * 8; } }
    for (int it = it0; it < itend; it += itstep) {
        const int lq = it / PL; int r = PL - 1 - (it - lq * PL); const int l = NLAYER - 1 - lq;
        const float* src; bf16_t* dst; int ldw, ldk;
        if (r < NI_WIN) { const int kb = r / 112, nb = r % 112; ldw = INC; ldk = DM;
            src = p.in[I_WIN] + (size_t)l * DM * INC + (size_t)(64 * kb) * INC + 32 * nb;
            dst = (bf16_t*)(p.ws + WS_WIN + l * SZ_WIN) + (size_t)(32 * nb) * DM + 64 * kb; }
        else if ((r -= NI_WIN) < NI_WOUT) { const int kb = r / 64, nb = r % 64; ldw = DM; ldk = DM;
            src = p.in[I_WOUT] + (size_t)l * DM * DM + (size_t)(64 * kb) * DM + 32 * nb;
            dst = (bf16_t*)(p.ws + WS_WOUT + l * SZ_WOUT) + (size_t)(32 * nb) * DM + 64 * kb; }
        else if ((r -= NI_WOUT) < NI_WFI) { const int kb = r / 352, nb = r % 352; ldw = 2 * DFF; ldk = DM;
            const int n0 = 32 * nb, half = n0 / DFF, idx = n0 - half * DFF, drow = (idx >> 7) * 256 + half * 128 + (idx & 127);
            src = p.in[I_WFI] + (size_t)l * DM * 2 * DFF + (size_t)(64 * kb) * (2 * DFF) + n0;
            dst = (bf16_t*)(p.ws + WS_WFI + l * SZ_WFI) + (size_t)drow * DM + 64 * kb; }
        else if ((r -= NI_WFI) < NI_WFO) { const int kb = r / 64, nb = r % 64; ldw = DM; ldk = DFF;
            src = p.in[I_WFO] + (size_t)l * DFF * DM + (size_t)(64 * kb) * DM + 32 * nb;
            dst = (bf16_t*)(p.ws + WS_WFO + l * SZ_WFO) + (size_t)(32 * nb) * DFF + 64 * kb; }
        else { r -= NI_WFO; const int mat = r >> 3, sub = r & 7, kb = sub >> 2, nb = sub & 3; ldw = 128; ldk = 128;
            src = p.in[I_LRUW] + (size_t)(l * 16 + mat) * 16384 + (size_t)(64 * kb) * 128 + 32 * nb;
            dst = (bf16_t*)(p.ws + WS_LRUW + l * SZ_LRUW) + (size_t)mat * 16384 + (size_t)(32 * nb) * 128 + 64 * kb; }
        transpose_item(src, ldw, dst, ldk, scr, lane);
    }
    bf16_t* WSB = (bf16_t*)(p.ws + WS_WSB);
    for (int i = blockIdx.x * 512 + tid; i < NLAYER * 4 * 128 * 128; i += gridDim.x * 512) WSB[i] = f2bf(p.in[I_WS][i]);
}

__device__ __forceinline__ void load_row(const float* rp, int lane, f32x4_t (&v)[8]) {
    const f32x4_t* q = (const f32x4_t*)rp + lane;
#pragma unroll
    for (int j = 0; j < 8; ++j) v[j] = __builtin_nontemporal_load(q + 64 * j);
}
__device__ __forceinline__ float row_rstd(const f32x4_t (&v)[8]) {
    float s = 0.f;
#pragma unroll
    for (int j = 0; j < 8; ++j) s += (v[j].x * v[j].x + v[j].y * v[j].y) + (v[j].z * v[j].z + v[j].w * v[j].w);
    return rsqrtf(wave_sum(s) * (1.f / DM) + EPS);
}
__device__ __forceinline__ void mod_store(const f32x4_t (&v)[8], float r, const float* g, const float* sh, const float* sc, bf16_t* dst, int lane) {
#pragma unroll
    for (int j = 0; j < 8; ++j) { const int col = 4 * (64 * j + lane);
        const f32x4_t g4 = *(const f32x4_t*)(g + col), sh4 = *(const f32x4_t*)(sh + col), sc4 = *(const f32x4_t*)(sc + col);
        const f32x4_t h = (v[j] * r * g4) * (1.f + sc4) + sh4;
        u32x2_t w; w.x = pk2bf(h.x, h.y); w.y = pk2bf(h.z, h.w);
        *(u32x2_t*)(dst + col) = w; }
}
__device__ __forceinline__ void load_vec8(const float* v, int lane, f32x4_t (&o)[8]) {
#pragma unroll
    for (int j = 0; j < 8; ++j) o[j] = *(const f32x4_t*)(v + 4 * (64 * j + lane));
}
__device__ __forceinline__ void store_h(const f32x4_t (&x)[8], float r, const f32x4_t (&cA)[8], const f32x4_t (&cS)[8], bf16_t* dst, int lane) {
#pragma unroll
    for (int j = 0; j < 8; ++j) { const f32x4_t h = (x[j] * r) * cA[j] + cS[j];
        u32x2_t w; w.x = pk2bf(h.x, h.y); w.y = pk2bf(h.z, h.w);
        *(u32x2_t*)(dst + 4 * (64 * j + lane)) = w; }
}
__device__ __forceinline__ void phaseA(const Params& p, int gw, int NGW, int lane) {
    const float* MOD = (const float*)(p.ws + WS_MOD); bf16_t* H = (bf16_t*)(p.ws + WS_HBUF);
    const int R = (MT + NGW - 1) / NGW; int cur = -1; f32x4_t cA[8], cS[8], v[8], vn[8];
    const int m0 = gw * R;
    if (m0 < MT) load_row(m0 < ML ? p.in[I_X] + (size_t)m0 * DM : p.in[I_CTX] + (size_t)(m0 - ML) * DM, lane, v);
    for (int k = 0; k < R; ++k) { const int m = m0 + k; if (m >= MT) break;
        const int mn = m + 1; const bool has_n = (k + 1 < R) && (mn < MT);
        if (has_n) load_row(mn < ML ? p.in[I_X] + (size_t)mn * DM : p.in[I_CTX] + (size_t)(mn - ML) * DM, lane, vn);
        const bool lat = m < ML; const int bi = lat ? (m >> 11) : 8;
        if (bi != cur) { cur = bi; const float* md = MOD + (size_t)bi * (6 * DM); f32x4_t g[8], sc[8]; load_vec8(p.in[I_GNORM], lane, g); load_vec8(md + DM, lane, sc); load_vec8(md, lane, cS);
#pragma unroll
            for (int j = 0; j < 8; ++j) cA[j] = g[j] * (1.f + sc[j]); }
        store_h(v, row_rstd(v), cA, cS, H + (size_t)m * DM, lane);
        if (has_n) {
#pragma unroll
            for (int j = 0; j < 8; ++j) v[j] = vn[j]; }
    }
}
template <bool XIN32, bool XOUT32>
__device__ __forceinline__ void row_update(const Params& p, int mcount, const float* modl, int gt_off, const float* gy, bool do_next, const float* gnext, const float* modn, int sh_off, int sc_off,
                                           int gw, int NGW, int lane) {
    const bf16_t* Y = (const bf16_t*)(p.ws + WS_YBUF); bf16_t* H = (bf16_t*)(p.ws + WS_HBUF); bf16_t* XB = (bf16_t*)(p.ws + WS_XB);
    const int R = (mcount + NGW - 1) / NGW; int cur = -1; f32x4_t c1[8], cA[8], cS[8];
    bool have_y = false, have_x = false; u32x2_t yn[8], xn[8];
    for (int k = 0; k < R; ++k) { const int m = gw * R + k; if (m >= mcount) break;
        const bool lat = m < ML; const int bi = lat ? (m >> 11) : 8;
        if (bi != cur) { cur = bi; f32x4_t a[8], b[8];
            load_vec8(modl + (size_t)bi * (6 * DM) + gt_off, lane, a); load_vec8(gy, lane, b);
#pragma unroll
            for (int j = 0; j < 8; ++j) c1[j] = a[j] * b[j];
            if (do_next) { const float* mn = modn + (size_t)bi * (6 * DM); load_vec8(gnext, lane, a); load_vec8(mn + sc_off, lane, b); load_vec8(mn + sh_off, lane, cS);
#pragma unroll
                for (int j = 0; j < 8; ++j) cA[j] = a[j] * (1.f + b[j]); } }
        f32x4_t y[8], x[8];
        if (lat) {
            if (!have_y) { const u32x2_t* yq = (const u32x2_t*)(Y + (size_t)m * DM) + lane;
#pragma unroll
                for (int j = 0; j < 8; ++j) yn[j] = __builtin_nontemporal_load(yq + 64 * j); }
#pragma unroll
            for (int j = 0; j < 8; ++j) y[j] = (f32x4_t){bflo(yn[j].x), bfhi(yn[j].x), bflo(yn[j].y), bfhi(yn[j].y)}; }
        else { const u32x2_t* yp = (const u32x2_t*)((const bf16_t*)(p.ws + WS_YPART) + (size_t)(m - ML) * DM) + lane;
          constexpr size_t PS = (size_t)MC * DM / 4;
#pragma unroll
          for (int j = 0; j < 8; ++j) { const u32x2_t a = __builtin_nontemporal_load(yp + 64 * j), b = __builtin_nontemporal_load(yp + 64 * j + PS), c = __builtin_nontemporal_load(yp + 64 * j + 2 * PS), d = __builtin_nontemporal_load(yp + 64 * j + 3 * PS);
              y[j] = ((f32x4_t){bflo(a.x), bfhi(a.x), bflo(a.y), bfhi(a.y)} + (f32x4_t){bflo(b.x), bfhi(b.x), bflo(b.y), bfhi(b.y)})
                   + ((f32x4_t){bflo(c.x), bfhi(c.x), bflo(c.y), bfhi(c.y)} + (f32x4_t){bflo(d.x), bfhi(d.x), bflo(d.y), bfhi(d.y)}); } }
        if (XIN32) load_row(lat ? p.in[I_X] + (size_t)m * DM : p.in[I_CTX] + (size_t)(m - ML) * DM, lane, x);
        else {
            if (!have_x) { const u32x2_t* xq = (const u32x2_t*)(XB + (size_t)m * DM) + lane;
#pragma unroll
                for (int j = 0; j < 8; ++j) xn[j] = __builtin_nontemporal_load(xq + 64 * j); }
#pragma unroll
            for (int j = 0; j < 8; ++j) x[j] = (f32x4_t){bflo(xn[j].x), bfhi(xn[j].x), bflo(xn[j].y), bfhi(xn[j].y)}; }
        { const int mn = m + 1; const bool nx = (k + 1 < R) && (mn < mcount);
          have_y = nx && (mn < ML); have_x = nx && !XIN32;
          if (have_y) { const u32x2_t* yq = (const u32x2_t*)(Y + (size_t)mn * DM) + lane;
#pragma unroll
              for (int j = 0; j < 8; ++j) yn[j] = __builtin_nontemporal_load(yq + 64 * j); }
          if (have_x) { const u32x2_t* xq = (const u32x2_t*)(XB + (size_t)mn * DM) + lane;
#pragma unroll
              for (int j = 0; j < 8; ++j) xn[j] = __builtin_nontemporal_load(xq + 64 * j); } }
        const float ry = row_rstd(y);
#pragma unroll
        for (int j = 0; j < 8; ++j) { x[j] = x[j] + c1[j] * (y[j] * ry);
            if (XOUT32) __builtin_nontemporal_store(x[j], (f32x4_t*)(p.out + (size_t)m * DM + 4 * (64 * j + lane)));
            else { u32x2_t w; w.x = pk2bf(x[j].x, x[j].y); w.y = pk2bf(x[j].z, x[j].w); __builtin_nontemporal_store(w, (u32x2_t*)(XB + (size_t)m * DM + 4 * (64 * j + lane))); } }
        if (do_next) store_h(x, row_rstd(x), cA, cS, H + (size_t)m * DM, lane);
    }
}

#ifdef ATT_QFUSE
#define QK_PS0 2
#else
#define QK_PS0 0
#endif
__device__ __forceinline__ void qk_rows(const Params& p, int l, int gw, int NGW, int lane) {
    bf16_t* P = (bf16_t*)(p.ws + WS_PBUF); bf16_t* KB = (bf16_t*)(p.ws + WS_KBUF); bf16_t* VB = (bf16_t*)(p.ws + WS_VBUF);
    const float* gqk = p.in[I_GQK] + l * 256;
    const int hs = lane >> 4, sub = lane & 15, a = sub >> 3;
    const float sgn = (sub & 4) ? 1.f : -1.f;
    float invf[8], gq[8], gk[8];
#pragma unroll
    for (int e = 0; e < 8; ++e) { const int i = (sub & 3) * 8 + e; invf[e] = exp2f(-(float)(2 * i) * (13.287712379549449f / 64.f)); gq[e] = gqk[sub * 8 + e]; gk[e] = gqk[128 + sub * 8 + e]; }
    u32x4_t w[3];
    if (gw < MT) {
#pragma unroll
        for (int ps = QK_PS0; ps < 3; ++ps) w[ps] = *(const u32x4_t*)(P + (size_t)gw * INC + ps * 512 + lane * 8);
    }
    for (int m = gw; m < MT; m += NGW) {
        u32x4_t wn[3]; const int mn = m + NGW;
        if (mn < MT) {
#pragma unroll
            for (int ps = QK_PS0; ps < 3; ++ps) wn[ps] = *(const u32x4_t*)(P + (size_t)mn * INC + ps * 512 + lane * 8);
        }
        const bool lat = m < ML; int b, keypos; float cs[8], sn[8];
        if (lat) { b = m >> 11; const int n = m & (SEQ - 1); keypos = CTXL + n; const float pos = (float)(a == 0 ? (n >> 6) : (n & 63));
#pragma unroll
            for (int e = 0; e < 8; ++e) { const float ang = pos * invf[e]; const float kf = rintf(ang * 0.15915494309189535f);
                float rr = fmaf(-kf, 6.2831854820251465f, ang); rr = fmaf(-kf, -1.7484555e-7f, rr); cs[e] = __cosf(rr); sn[e] = __sinf(rr); } }
        else { const int mc = m - ML; b = mc >> 8; keypos = mc & (CTXL - 1);
#pragma unroll
            for (int e = 0; e < 8; ++e) { cs[e] = 1.f; sn[e] = 0.f; } }
        bf16_t* pr = P + (size_t)m * INC;
#pragma unroll
        for (int ps = QK_PS0; ps < 3; ++ps) {
            if (ps == 2 && hs >= 2) {
                *(u32x4_t*)(VB + ((size_t)(b * 2 + (hs - 2)) * SKV + keypos) * 128 + sub * 8) = w[ps];
            } else {
                float x[8]; x[0] = bflo(w[ps].x); x[1] = bfhi(w[ps].x); x[2] = bflo(w[ps].y); x[3] = bfhi(w[ps].y); x[4] = bflo(w[ps].z); x[5] = bfhi(w[ps].z); x[6] = bflo(w[ps].w); x[7] = bfhi(w[ps].w);
                float ss = 0.f;
#pragma unroll
                for (int e = 0; e < 8; ++e) ss += x[e] * x[e];
                ss += __shfl_xor(ss, 1); ss += __shfl_xor(ss, 2); ss += __shfl_xor(ss, 4); ss += __shfl_xor(ss, 8);
                const float rs = rsqrtf(ss * (1.f / 128.f) + EPS);
                float o[8];
#pragma unroll
                for (int e = 0; e < 8; ++e) { const float y = x[e] * rs * (ps < 2 ? gq[e] : gk[e]); const float yp = __shfl_xor(y, 4); o[e] = y * cs[e] + sgn * yp * sn[e]; }
                u32x4_t ow; ow.x = pk2bf(o[0], o[1]); ow.y = pk2bf(o[2], o[3]); ow.z = pk2bf(o[4], o[5]); ow.w = pk2bf(o[6], o[7]);
                if (ps < 2) *(u32x4_t*)(pr + ps * 512 + lane * 8) = ow;
                else *(u32x4_t*)(KB + ((size_t)(b * 2 + hs) * SKV + keypos) * 128 + sub * 8) = ow;
            }
        }
#pragma unroll
        for (int ps = QK_PS0; ps < 3; ++ps) w[ps] = wn[ps];
    }
}

constexpr int TS = 136;
__device__ __forceinline__ void tile_mma(f32x4_t (&acc)[8], const LAS bf16_t* X, const LAS bf16_t* Y, int wid, int fr, int fq) {
#pragma unroll
    for (int kk = 0; kk < 4; ++kk) {
        const bf16x8_t av = *(const LAS bf16x8_t*)(X + (16 * wid + fr) * TS + kk * 32 + fq * 8);
#pragma unroll
        for (int jb = 0; jb < 8; ++jb) { const bf16x8_t bv = *(const LAS bf16x8_t*)(Y + (16 * jb + fr) * TS + kk * 32 + fq * 8);
            acc[jb] = __builtin_amdgcn_mfma_f32_16x16x32_bf16(av, bv, acc[jb], 0, 0, 0); }
    }
}
__device__ __forceinline__ void stage_tile(LAS bf16_t* T, const bf16_t* src, int ld, int tid) {
    u32x4_t v[4];
#pragma unroll
    for (int q = 0; q < 4; ++q) { const int idx = tid + 512 * q, row = idx >> 4, c8 = (idx & 15) * 8; v[q] = *(const u32x4_t*)(src + (size_t)row * ld + c8); }
#pragma unroll
    for (int q = 0; q < 4; ++q) { const int idx = tid + 512 * q, row = idx >> 4, c8 = (idx & 15) * 8; *(LAS u32x4_t*)(T + row * TS + c8) = v[q]; }
}

__device__ __forceinline__ void mlp_item(const Params& p, int l, int ck, int g, LAS unsigned char* lds, int tid_in, int wid, int lane_in) {
    int tid = tid_in; asm volatile("" : "+v"(tid)); const int lane = tid & 63; (void)lane_in;
    const bf16_t* P = (const bf16_t*)(p.ws + WS_PBUF); bf16_t* H = (bf16_t*)(p.ws + WS_HBUF);
    LAS bf16_t* X = (LAS bf16_t*)lds; LAS bf16_t* Y = X + 128 * TS;
    const int row0 = ck * 128, fr = lane & 15, fq = lane >> 4;
    u32x4_t vw[2][2], xw[4]; unsigned short uu[4][8]; float bsv[4];
#pragma unroll
    for (int o = 0; o < 2; ++o)
#pragma unroll
        for (int e = 0; e < 2; ++e) vw[o][e] = *(const u32x4_t*)(P + (size_t)(row0 + 2 * lane + e) * INC + (ZM_OFF + 512) + g * 128 + (2 * wid + o) * 8);
    { const bf16_t* src = (const bf16_t*)(p.ws + WS_WSB) + (size_t)(l * 4 + g) * 16384;
#pragma unroll
      for (int q = 0; q < 4; ++q) { const int idx = tid + 512 * q, row = idx >> 4, c8 = (idx & 15) * 8; xw[q] = *(const u32x4_t*)(src + (size_t)row * 128 + c8); } }
    const float* bs = p.in[I_BS] + (l * 4 + g) * 128;
#pragma unroll
    for (int r = 0; r < 4; ++r) { const int pi = 16 * wid + 4 * fq + r; bsv[r] = bs[pi];
        const bf16_t* ur = P + (size_t)(row0 + pi) * INC + ZM_OFF + g * 128;
#pragma unroll
        for (int jb = 0; jb < 8; ++jb) uu[r][jb] = ur[jb * 16 + fr]; }
#pragma unroll
    for (int q = 0; q < 4; ++q) { const int idx = tid + 512 * q, row = idx >> 4, c8 = (idx & 15) * 8; *(LAS u32x4_t*)(X + row * TS + c8) = xw[q]; }
#pragma unroll
    for (int o = 0; o < 2; ++o) { const int c8 = (2 * wid + o) * 8; const u32x4_t a = vw[o][0], b = vw[o][1];
        LAS unsigned* Yd = (LAS unsigned*)(Y + c8 * TS + 2 * lane);
        Yd[0 * (TS / 2)] = pk2bf(gelu_tanh(bflo(a.x)), gelu_tanh(bflo(b.x))); Yd[1 * (TS / 2)] = pk2bf(gelu_tanh(bfhi(a.x)), gelu_tanh(bfhi(b.x)));
        Yd[2 * (TS / 2)] = pk2bf(gelu_tanh(bflo(a.y)), gelu_tanh(bflo(b.y))); Yd[3 * (TS / 2)] = pk2bf(gelu_tanh(bfhi(a.y)), gelu_tanh(bfhi(b.y)));
        Yd[4 * (TS / 2)] = pk2bf(gelu_tanh(bflo(a.z)), gelu_tanh(bflo(b.z))); Yd[5 * (TS / 2)] = pk2bf(gelu_tanh(bfhi(a.z)), gelu_tanh(bfhi(b.z)));
        Yd[6 * (TS / 2)] = pk2bf(gelu_tanh(bflo(a.w)), gelu_tanh(bflo(b.w))); Yd[7 * (TS / 2)] = pk2bf(gelu_tanh(bfhi(a.w)), gelu_tanh(bfhi(b.w))); }
    __syncthreads();
    f32x4_t acc[8];
#pragma unroll
    for (int jb = 0; jb < 8; ++jb) acc[jb] = (f32x4_t){0.f, 0.f, 0.f, 0.f};
    tile_mma(acc, X, Y, wid, fr, fq);
#pragma unroll
    for (int r = 0; r < 4; ++r) { const int pi = 16 * wid + 4 * fq + r;
        bf16_t* orow = H + (size_t)(row0 + pi) * DM + 1024 + g * 128;
#pragma unroll
        for (int jb = 0; jb < 8; ++jb) { const int c = jb * 16 + fr; orow[c] = f2bf(gelu_tanh(bf2f(uu[r][jb])) * (acc[jb][r] + bsv[r])); } }
    __syncthreads();
}

#ifdef PROBE_MASK
#define PROBE_ARGS , unsigned long long& ts_, unsigned long long& tsel_
#define PROBE_PASS , ts_, tsel_
#define ISTAMP(bit) do { const unsigned long long n_ = wall_clock64(); if ((PROBE_MASK) & (1u << (bit))) tsel_ += n_ - ts_; ts_ = n_; } while (0)
#else
#define PROBE_ARGS
#define PROBE_PASS
#define ISTAMP(bit) do {} while (0)
#endif
__device__ __forceinline__ void lru1_item(const Params& p, int l, int ck, int h, int d, LAS unsigned char* lds, int tid_in, int wid, int lane_in PROBE_ARGS) {
    int tid = tid_in; asm volatile("" : "+v"(tid)); const int lane = tid & 63; (void)lane_in;
    const bf16_t* P = (const bf16_t*)(p.ws + WS_PBUF);
    LAS bf16_t* X = (LAS bf16_t*)lds; LAS bf16_t* Y = X + 128 * TS; LAS float* WT = (LAS float*)(lds + 131072 + 64);
    const int fr = lane & 15, fq = lane >> 4;
    int seqbase, L, jc;
    if (ck < 128) { seqbase = (ck >> 4) * SEQ; L = SEQ; jc = ck & 15; } else { const int c2 = ck - 128; seqbase = ML + (c2 >> 1) * CTXL; L = CTXL; jc = c2 & 1; }
    const float* cw = p.in[I_CONVW] + l * 4 * 512 + h * 128; const float* cb = p.in[I_CONVB] + l * 512 + h * 128;
    const bf16_t* LW = (const bf16_t*)(p.ws + WS_LRUW + l * SZ_LRUW);
    const float* lb = p.in[I_LRUB] + (size_t)((l * 2 + d) * 2) * 512 + h * 128; const float* lam = p.in[I_LRULAM] + (l * 2 + d) * 512 + h * 128;
    u32x4_t wga[4], wgx[4];
#pragma unroll
    for (int q = 0; q < 4; ++q) { const int idx = tid + 512 * q, row = idx >> 4, c8 = (idx & 15) * 8;
        wga[q] = *(const u32x4_t*)(LW + (size_t)((d * 2 + 0) * 4 + h) * 16384 + (size_t)row * 128 + c8);
        wgx[q] = *(const u32x4_t*)(LW + (size_t)((d * 2 + 1) * 4 + h) * 16384 + (size_t)row * 128 + c8); }
    {
        const int c8 = (tid & 15) * 8, t0 = tid >> 4;
        f32x4_t w0[4], w1[4];
#pragma unroll
        for (int tap = 0; tap < 4; ++tap) { w0[tap] = *(const f32x4_t*)(cw + tap * 512 + c8); w1[tap] = *(const f32x4_t*)(cw + tap * 512 + c8 + 4); }
        const f32x4_t b0 = *(const f32x4_t*)(cb + c8), b1 = *(const f32x4_t*)(cb + c8 + 4);
#pragma unroll
        for (int hf = 0; hf < 2; ++hf) {
            u32x4_t pw[2][4]; float vm[2][4];
#pragma unroll
            for (int q2 = 0; q2 < 2; ++q2)
#pragma unroll
                for (int tap = 0; tap < 4; ++tap) { const int pos = jc * 128 + t0 + 32 * (2 * hf + q2) + tap - 2, posc = min(max(pos, 0), L - 1);
                    vm[q2][tap] = (pos == posc) ? 1.f : 0.f;
                    pw[q2][tap] = *(const u32x4_t*)(P + (size_t)(seqbase + posc) * INC + ZX_OFF + h * 128 + c8); }
#pragma unroll
            for (int q2 = 0; q2 < 2; ++q2) { f32x4_t x0 = b0, x1 = b1;
#pragma unroll
                for (int tap = 0; tap < 4; ++tap) { const u32x4_t w = pw[q2][tap]; const f32x4_t a0 = w0[tap] * vm[q2][tap], a1 = w1[tap] * vm[q2][tap];
                    x0 += (f32x4_t){bflo(w.x), bfhi(w.x), bflo(w.y), bfhi(w.y)} * a0; x1 += (f32x4_t){bflo(w.z), bfhi(w.z), bflo(w.w), bfhi(w.w)} * a1; }
                u32x4_t o; o.x = pk2bf(x0.x, x0.y); o.y = pk2bf(x0.z, x0.w); o.z = pk2bf(x1.x, x1.y); o.w = pk2bf(x1.z, x1.w);
                *(LAS u32x4_t*)(X + (t0 + 32 * (2 * hf + q2)) * TS + c8) = o; }
        }
    }
    LAS bf16_t* Y2 = Y + 128 * TS;
#pragma unroll
    for (int q = 0; q < 4; ++q) { const int idx = tid + 512 * q, row = idx >> 4, c8 = (idx & 15) * 8; *(LAS u32x4_t*)(Y + row * TS + c8) = wga[q]; *(LAS u32x4_t*)(Y2 + row * TS + c8) = wgx[q]; }
    __syncthreads(); ISTAMP(20);
    float cba[8], cbx[8], clam[8];
#pragma unroll
    for (int jb = 0; jb < 8; ++jb) { const int jj = jb * 16 + fr; cba[jb] = lb[jj]; cbx[jb] = lb[512 + jj]; clam[jb] = lam[jj]; }
    f32x4_t accR[8], accI[8];
#pragma unroll
    for (int jb = 0; jb < 8; ++jb) { accR[jb] = (f32x4_t){0.f, 0.f, 0.f, 0.f}; accI[jb] = (f32x4_t){0.f, 0.f, 0.f, 0.f}; }
    tile_mma(accR, X, Y, wid, fr, fq);
    tile_mma(accI, X, Y2, wid, fr, fq); ISTAMP(21);
    const int src1 = (d == 0 ? lane - 16 : lane + 16) & 63, src2 = (d == 0 ? lane - 32 : lane + 32) & 63;
    const bool v1 = d == 0 ? (fq >= 1) : (fq <= 2), v2 = d == 0 ? (fq >= 2) : (fq <= 1), lastq = d == 0 ? (fq == 3) : (fq == 0);
    float Al[8][4], hl[8][4], Aq[8], hq[8];
#pragma unroll
    for (int jb = 0; jb < 8; ++jb) { const int jj = jb * 16 + fr;
        const float ba = cba[jb], bxb = cbx[jb], sp8 = -8.f * log1pf(expf(-clam[jb]));
        float a4[4], b4[4];
#pragma unroll
        for (int r = 0; r < 4; ++r) {
            const float xv = bf2f(X[(16 * wid + 4 * fq + r) * TS + jj]);
            const float rg = sigmoid_f(accR[jb][r] + ba), ig = sigmoid_f(accI[jb][r] + bxb);
            const float la = sp8 * rg, z = 2.f * la;
            const float om = -z * (1.f + z * (0.5f + z * (0.16666667f + z * (0.041666668f + z * (0.0083333338f + z * 0.0013888889f)))));
            a4[r] = __expf(la); b4[r] = __builtin_amdgcn_sqrtf(om) * (ig * xv); }
        float A, hs;
        if (d == 0) { A = a4[0]; hs = b4[0]; Al[jb][0] = A; hl[jb][0] = hs;
#pragma unroll
            for (int r = 1; r < 4; ++r) { hs = a4[r] * hs + b4[r]; A *= a4[r]; Al[jb][r] = A; hl[jb][r] = hs; } }
        else { A = a4[3]; hs = b4[3]; Al[jb][3] = A; hl[jb][3] = hs;
#pragma unroll
            for (int r = 2; r >= 0; --r) { hs = a4[r] * hs + b4[r]; A *= a4[r]; Al[jb][r] = A; hl[jb][r] = hs; } }
        { const float Ap = __shfl(A, src1), hp = __shfl(hs, src1); if (v1) { hs = A * hp + hs; A = Ap * A; } }
        { const float Ap = __shfl(A, src2), hp = __shfl(hs, src2); if (v2) { hs = A * hp + hs; A = Ap * A; } }
        { const float Ap = __shfl(A, src1), hp = __shfl(hs, src1); Aq[jb] = v1 ? Ap : 1.f; hq[jb] = v1 ? hp : 0.f; }
        if (lastq) { WT[(wid * 128 + jj) * 2 + 0] = A; WT[(wid * 128 + jj) * 2 + 1] = hs; }
    }
    ISTAMP(22); __syncthreads();
    bf16_t* AC = (bf16_t*)(p.ws + WS_YBUF) + (size_t)(d * 2 + 0) * MT * 512; bf16_t* HL = (bf16_t*)(p.ws + WS_YBUF) + (size_t)(d * 2 + 1) * MT * 512;
    LAS float* SA = (LAS float*)lds; LAS float* SB = SA + 16384;
    const bool lastw = d == 0 ? (wid == 7) : (wid == 0);
#pragma unroll
    for (int jb = 0; jb < 8; ++jb) { const int jj = jb * 16 + fr;
        float Aw = 1.f, hw = 0.f;
        f32x2_t wt[8];
#pragma unroll
        for (int w = 0; w < 8; ++w) wt[w] = *(const LAS f32x2_t*)(WT + (w * 128 + jj) * 2);
#pragma unroll
        for (int q = 0; q < 8; ++q) { const int w = d == 0 ? q : 7 - q; const bool use = d == 0 ? (w < wid) : (w > wid);
            const f32x2_t v = d == 0 ? wt[q] : wt[7 - q]; (void)w;
            if (use) { hw = v.x * hw + v.y; Aw *= v.x; } }
        const float PA = Aw * Aq[jb], Ph = Aq[jb] * hw + hq[jb];
#pragma unroll
        for (int r = 0; r < 4; ++r) { const int t = 16 * wid + 4 * fq + r, so = t * 128 + (jj ^ ((fq & 1) << 4));
            const float Ac = PA * Al[jb][r], hc = Al[jb][r] * Ph + hl[jb][r];
            SA[so] = Ac; SB[so] = hc;
            if (lastw && lastq && r == (d == 0 ? 3 : 0)) { float* AG = (float*)(p.ws + WS_AGG) + ((size_t)(d * NCHUNK + ck) * 512 + h * 128 + jj) * 2; AG[0] = Ac; AG[1] = hc; } }
    }
    __syncthreads(); ISTAMP(23);
#pragma unroll
    for (int q8 = 0; q8 < 8; ++q8) { const int idx = tid + 512 * q8, t = idx >> 5, c4 = (idx & 31) * 4, so = t * 128 + (c4 ^ (((t >> 2) & 1) << 4)); const size_t go = (size_t)(ck * 128 + t) * 512 + h * 128 + c4;
        const f32x4_t va = *(const LAS f32x4_t*)(SA + so), vh = *(const LAS f32x4_t*)(SB + so);
        u32x2_t wa, wh; wa.x = pk2bf(va.x, va.y); wa.y = pk2bf(va.z, va.w); wh.x = pk2bf(vh.x, vh.y); wh.y = pk2bf(vh.z, vh.w);
        *(u32x2_t*)(AC + go) = wa; *(u32x2_t*)(HL + go) = wh; }
    __syncthreads();
}

__device__ __forceinline__ void lru2_item(const Params& p, int ck, int h, LAS unsigned char* lds, int tid_in) {
    int tid = tid_in; asm volatile("" : "+v"(tid));
    const bf16_t* P = (const bf16_t*)(p.ws + WS_PBUF); bf16_t* H = (bf16_t*)(p.ws + WS_HBUF);
    LAS float* CR = (LAS float*)lds;
    const bf16_t* Yb = (const bf16_t*)(p.ws + WS_YBUF); const size_t AS = (size_t)MT * 512;
    u32x2_t ra0[8], rh0[8], ra1[8], rh1[8], rzg[8];
#pragma unroll
    for (int q8 = 0; q8 < 8; ++q8) { const int idx = tid + 512 * q8, t = idx >> 5, c4 = (idx & 31) * 4; const size_t row = (size_t)ck * 128 + t, go = row * 512 + h * 128 + c4;
        ra0[q8] = *(const u32x2_t*)(Yb + go); rh0[q8] = *(const u32x2_t*)(Yb + AS + go); ra1[q8] = *(const u32x2_t*)(Yb + 2 * AS + go); rh1[q8] = *(const u32x2_t*)(Yb + 3 * AS + go);
        rzg[q8] = *(const u32x2_t*)(P + row * INC + ZG_OFF + h * 128 + c4); }
    if (tid < 256) { const int d = tid >> 7, j = tid & 127; const float* AG = (const float*)(p.ws + WS_AGG) + (size_t)d * NCHUNK * 1024 + (h * 128 + j) * 2;
        f32x2_t ag[18];
        if (ck < 128) { const int b = ck >> 4, jc = ck & 15, cc0 = 128 + 2 * b;
            ag[0] = *(const f32x2_t*)(AG + (size_t)(d == 0 ? cc0 : cc0 + 1) * 1024); ag[1] = *(const f32x2_t*)(AG + (size_t)(d == 0 ? cc0 + 1 : cc0) * 1024);
#pragma unroll
            for (int q = 0; q < 16; ++q) { const int lq = d == 0 ? q : 15 - q; const bool valid = d == 0 ? (lq < jc) : (lq > jc);
                ag[2 + q] = valid ? *(const f32x2_t*)(AG + (size_t)(b * 16 + lq) * 1024) : (f32x2_t){1.f, 0.f}; } }
        else { const int jc = (ck - 128) & 1; const bool valid = d == 0 ? (jc == 1) : (jc == 0); const int qn = d == 0 ? ck - 1 : ck + 1;
            ag[0] = valid ? *(const f32x2_t*)(AG + (size_t)qn * 1024) : (f32x2_t){1.f, 0.f};
#pragma unroll
            for (int q = 1; q < 18; ++q) ag[q] = (f32x2_t){1.f, 0.f}; }
        float c = 0.f;
#pragma unroll
        for (int q = 0; q < 18; ++q) c = ag[q].x * c + ag[q].y;
        CR[tid] = c; }
    __syncthreads();
#pragma unroll
    for (int q8 = 0; q8 < 8; ++q8) { const int idx = tid + 512 * q8, t = idx >> 5, c4 = (idx & 31) * 4; const size_t row = (size_t)ck * 128 + t;
        const u32x2_t wa0 = ra0[q8], wh0 = rh0[q8], wa1 = ra1[q8], wh1 = rh1[q8];
        const f32x4_t a0 = {bflo(wa0.x), bfhi(wa0.x), bflo(wa0.y), bfhi(wa0.y)}, h0 = {bflo(wh0.x), bfhi(wh0.x), bflo(wh0.y), bfhi(wh0.y)};
        const f32x4_t a1 = {bflo(wa1.x), bfhi(wa1.x), bflo(wa1.y), bfhi(wa1.y)}, h1 = {bflo(wh1.x), bfhi(wh1.x), bflo(wh1.y), bfhi(wh1.y)};
        const f32x4_t c0 = *(const LAS f32x4_t*)(CR + c4), c1 = *(const LAS f32x4_t*)(CR + 128 + c4);
        const u32x2_t zg = rzg[q8];
        const f32x4_t hs = a0 * c0 + h0 + a1 * c1 + h1;
        u32x2_t o; o.x = pk2bf(hs.x * gelu_tanh(bflo(zg.x)), hs.y * gelu_tanh(bfhi(zg.x))); o.y = pk2bf(hs.z * gelu_tanh(bflo(zg.y)), hs.w * gelu_tanh(bfhi(zg.y)));
        *(u32x2_t*)(H + row * DM + 1536 + h * 128 + c4) = o; }
    __syncthreads();
}

typedef const __attribute__((address_space(4))) Params* KParams;
#define PH_BEGIN() KParams kp_ = (KParams)__builtin_amdgcn_kernarg_segment_ptr(); asm volatile("" : "+s"(kp_)); Params p; _Pragma("unroll") for (int i_ = 0; i_ < 19; ++i_) p.in[i_] = kp_->in[i_]; p.out = kp_->out; p.ws = kp_->ws; \
    int tid_o = threadIdx.x; asm volatile("" : "+v"(tid_o)); const int tid = tid_o, wid = __builtin_amdgcn_readfirstlane(tid >> 6), lane = tid & 63, gw = blockIdx.x * 8 + wid; \
    unsigned char* const ws = p.ws; (void)gw; (void)lane; (void)tid; (void)ws
__global__ void __launch_bounds__(512, 2) mega_fwd(Params p_arg) {
    extern __shared__ __attribute__((aligned(16))) unsigned char shm[];
    cg::grid_group grid = cg::this_grid();
    LAS unsigned char* lds = (LAS unsigned char*)shm;
    volatile LAS unsigned* bst = (volatile LAS unsigned*)(lds + 131072);
    if (threadIdx.x == 0) { bst[0] = 0u; bst[1] = 0u; }
    __syncthreads();
    (void)xcd_barrier_post((unsigned*)(p_arg.ws + WS_BAR), bst);
#define GSYNC() do { KParams kq_ = (KParams)__builtin_amdgcn_kernarg_segment_ptr(); asm volatile("" : "+s"(kq_)); XcdBarrier xb_; xb_.bar = (unsigned*)(kq_->ws + WS_BAR); { unsigned x_ = xb_xcc_id(); asm volatile("" : "+s"(x_)); xb_.x = x_; } \
        xb_.st = (volatile LAS unsigned*)((LAS unsigned char*)shm + 131072); xcd_barrier(xb_); } while (0)
    const int G = gridDim.x, NGW = G * 8;
#ifdef PROBE_MASK
    unsigned long long ts_ = wall_clock64(), tsel_ = 0ull;
#define STAMP(bit) do { const unsigned long long n_ = wall_clock64(); if ((PROBE_MASK) & (1u << (bit))) tsel_ += n_ - ts_; ts_ = n_; } while (0)
#else
#define STAMP(bit) do {} while (0)
#endif

#ifndef NO_P0
    { PH_BEGIN(); phase0(p, lds, tid, wid, lane); }
#endif
    if (p_arg.ws == nullptr) grid.sync();
    GSYNC(); STAMP(0);
#ifndef NO_ROWS
    { PH_BEGIN(); phaseA(p, gw, NGW, lane); }
#endif
    GSYNC(); STAMP(1);
#ifdef EXTRA_SYNCS
    for (int i_ = 0; i_ < EXTRA_SYNCS; ++i_) GSYNC();
#endif

#pragma unroll 1
    for (int l = 0; l < NLAYER; ++l) {
        const bool last = (l == NLAYER - 1);
        const int mrows = last ? ML : MT;
#ifndef NO_G1
        { PH_BEGIN(); pg8::StaticOrder S; S.init(MT, INC, G, blockIdx.x); pg8::EpiBf16 E{(bf16_t*)(ws + WS_PBUF), INC};
          pg8::gemm_phase<pg8::EpiBf16, pg8::StaticOrder, false>(lds, pg8::Gemm{(const bf16_t*)(ws + WS_HBUF), (const bf16_t*)(ws + WS_WIN + l * SZ_WIN), MT, INC, DM, DM}, S, E, nullptr); }
#endif
        GSYNC(); STAMP(2);
#ifndef NO_C
        { PH_BEGIN(); const int n_lru = NCHUNK * 8, n_mlp = (last ? 128 : NCHUNK) * 4;
          for (int it = blockIdx.x; it < n_lru + n_mlp; it += G) {
              if (it < n_lru) { lru1_item(p, l, it >> 3, (it >> 1) & 3, it & 1, lds, tid, wid, lane PROBE_PASS); STAMP(10); }
              else { const int r = it - n_lru; mlp_item(p, l, r >> 2, r & 3, lds, tid, wid, lane); STAMP(11); } }
          qk_rows(p, l, gw, NGW, lane); STAMP(12); }
#endif
        GSYNC(); STAMP(3);
#ifndef NO_D
        { PH_BEGIN(); const int n_att = 512 + (last ? 0 : 64), n_l2 = (last ? 128 : NCHUNK) * 4;
          bf16_t* HB = (bf16_t*)(ws + WS_HBUF); const bf16_t* PB = (const bf16_t*)(ws + WS_PBUF);
          for (int it = blockIdx.x; it < n_att + n_l2; it += G) {
              if (it < n_att) {
                  size_t qrow; int b, hq, seq;
                  if (it < 512) { b = it >> 6; hq = (it >> 3) & 7; const int qb = it & 7; qrow = (size_t)b * SEQ + qb * 256; seq = SKV; }
                  else { const int c = it - 512; b = c >> 3; hq = c & 7; qrow = (size_t)ML + b * CTXL; seq = CTXL; }
                  const size_t kvo = (size_t)(b * 2 + (hq >> 2)) * SKV * 128;
                  attn_dense_body<bf16>((const bf16*)(PB + qrow * INC + hq * 128), (const bf16*)((const bf16_t*)(ws + WS_KBUF) + kvo), (const bf16*)((const bf16_t*)(ws + WS_VBUF) + kvo),
                                        HB + qrow * DM + hq * 128, seq, (char*)shm, p.in[I_GQK] + l * 256, it < 512 ? (it & 7) * 256 : -1);
                  __syncthreads(); STAMP(13);
              } else {
#ifndef NO_L2
                  const int r = it - n_att; lru2_item(p, r >> 2, r & 3, lds, tid);
#endif
              } } }
#endif
        GSYNC(); STAMP(4);
#ifndef NO_G2
        { PH_BEGIN(); pg8::StaticOrder S; S.init(ML, DM, G, blockIdx.x); pg8::EpiBf16 E{(bf16_t*)(ws + WS_YBUF), DM};
          pg8::gemm_phase<pg8::EpiBf16, pg8::StaticOrder, false>(lds, pg8::Gemm{(const bf16_t*)(ws + WS_HBUF), (const bf16_t*)(ws + WS_WOUT + l * SZ_WOUT), ML, DM, DM, DM}, S, E, nullptr);
          if (!last) {
              pg8::SplitOrder S2; S2.init(MC, DM, 4, G, blockIdx.x); pg8::EpiBf16Split E2{(bf16_t*)(ws + WS_YPART), DM, (size_t)MC * DM};
              pg8::gemm_phase<pg8::EpiBf16Split, pg8::SplitOrder, false>(lds, pg8::Gemm{(const bf16_t*)(ws + WS_HBUF) + (size_t)ML * DM, (const bf16_t*)(ws + WS_WOUT + l * SZ_WOUT), MC, DM, DM / 4, DM}, S2, E2, nullptr); } }
#endif
        GSYNC(); STAMP(5);
#ifndef NO_ROWS
        { PH_BEGIN(); const float* gn = p.in[I_GNORM] + (size_t)l * 4 * DM; const float* ml = (const float*)(ws + WS_MOD) + (size_t)l * 9 * 6 * DM;
          if (l == 0) row_update<true, false>(p, mrows, ml, 2 * DM, gn + DM, true, gn + 2 * DM, ml, 3 * DM, 4 * DM, gw, NGW, lane);
          else row_update<false, false>(p, mrows, ml, 2 * DM, gn + DM, true, gn + 2 * DM, ml, 3 * DM, 4 * DM, gw, NGW, lane); }
#endif
        GSYNC(); STAMP(6);
#ifndef NO_G3
        { PH_BEGIN(); pg8::StaticOrder S; S.init(mrows, 2 * DFF, G, blockIdx.x); pg8::EpiSwiglu E{(bf16_t*)(ws + WS_PBUF), DFF};
          pg8::gemm_phase<pg8::EpiSwiglu, pg8::StaticOrder, false>(lds, pg8::Gemm{(const bf16_t*)(ws + WS_HBUF), (const bf16_t*)(ws + WS_WFI + l * SZ_WFI), mrows, 2 * DFF, DM, DM}, S, E, nullptr); }
#endif
        GSYNC(); STAMP(7);
#ifndef NO_G4
        { PH_BEGIN(); pg8::StaticOrder S; S.init(ML, DM, G, blockIdx.x); pg8::EpiBf16 E{(bf16_t*)(ws + WS_YBUF), DM};
          pg8::gemm_phase<pg8::EpiBf16, pg8::StaticOrder, false>(lds, pg8::Gemm{(const bf16_t*)(ws + WS_PBUF), (const bf16_t*)(ws + WS_WFO + l * SZ_WFO), ML, DM, DFF, DFF}, S, E, nullptr);
          if (!last) {
              pg8::SplitOrder S2; S2.init(MC, DM, 4, G, blockIdx.x); pg8::EpiBf16Split E2{(bf16_t*)(ws + WS_YPART), DM, (size_t)MC * DM};
              pg8::gemm_phase<pg8::EpiBf16Split, pg8::SplitOrder, false>(lds, pg8::Gemm{(const bf16_t*)(ws + WS_PBUF) + (size_t)ML * DFF, (const bf16_t*)(ws + WS_WFO + l * SZ_WFO), MC, DM, DFF / 4, DFF}, S2, E2, nullptr); } }
#endif
        GSYNC(); STAMP(8);
#ifndef NO_ROWS
        { PH_BEGIN(); const float* gn = p.in[I_GNORM] + (size_t)l * 4 * DM; const float* ml = (const float*)(ws + WS_MOD) + (size_t)l * 9 * 6 * DM;
          const float* gnn = p.in[I_GNORM] + (size_t)(last ? l : l + 1) * 4 * DM; const float* mln = (const float*)(ws + WS_MOD) + (size_t)(last ? l : l + 1) * 9 * 6 * DM;
          if (last) row_update<false, true>(p, mrows, ml, 5 * DM, gn + 3 * DM, false, gnn, mln, 0, DM, gw, NGW, lane);
          else row_update<false, false>(p, mrows, ml, 5 * DM, gn + 3 * DM, true, gnn, mln, 0, DM, gw, NGW, lane); }
#endif
        if (!last) { GSYNC(); STAMP(9); }
    }
#ifdef PROBE_MASK
    GSYNC(); STAMP(9);
    if (blockIdx.x == 0) { const float t_us = (float)tsel_ * 0.01f; const float delta = 0.1f * sqrtf(t_us * (1.f / 5000.f));
        for (int i = threadIdx.x; i < 65536; i += 512) p_arg.out[i] += delta; }
#endif
}

extern "C" void kernel_launch(void* const* d_in, const int* in_sizes, int n_in, void* d_out, int out_size, void* d_ws, size_t ws_size, hipStream_t stream) {
    static int grid_blocks = 0;
    if (grid_blocks == 0) {
        if (n_in != 19 || out_size != ML * DM || ws_size < WS_END) { fprintf(stderr, "kernel_launch: unexpected shapes (n_in %d out %d ws %zu need %zu)\n", n_in, out_size, ws_size, (size_t)WS_END); grid_blocks = -1; return; }
        int dev = 0, cus = 0, per_cu = 0;
        hipGetDevice(&dev);
        hipDeviceGetAttribute(&cus, hipDeviceAttributeMultiprocessorCount, dev);
        if (hipFuncSetAttribute((const void*)mega_fwd, hipFuncAttributeMaxDynamicSharedMemorySize, LDS_BYTES) != hipSuccess) { fprintf(stderr, "kernel_launch: hipFuncSetAttribute failed\n"); grid_blocks = -1; return; }
        if (hipOccupancyMaxActiveBlocksPerMultiprocessor(&per_cu, (const void*)mega_fwd, 512, LDS_BYTES) != hipSuccess || per_cu < 1) { fprintf(stderr, "kernel_launch: occupancy query failed (%d)\n", per_cu); per_cu = 1; }
        (void)hipGetLastError();
        grid_blocks = cus * 1;
    }
    if (grid_blocks < 0) return;
    if (hipMemsetAsync((char*)d_ws + WS_BAR, 0, XCD_BAR_WORDS * 4, stream) != hipSuccess) { fprintf(stderr, "kernel_launch: memset failed\n"); return; }
    Params p{};
    for (int i = 0; i < 19; ++i) p.in[i] = (const float*)d_in[i];
    p.out = (float*)d_out; p.ws = (unsigned char*)d_ws;
    void* args[] = {&p};
    hipError_t e = hipLaunchCooperativeKernel((const void*)mega_fwd, dim3(grid_blocks), dim3(512), args, LDS_BYTES, stream);
    if (e != hipSuccess) fprintf(stderr, "cooperative launch failed: %s (grid %d)\n", hipGetErrorString(e), grid_blocks);
}
```

```cpp
#define ATT_QFUSE 1
#include <hip/hip_runtime.h>
#include <hip/hip_bf16.h>
#include <hip/hip_cooperative_groups.h>
#include <cstdio>
#include <cstdint>
namespace cg = cooperative_groups;

#define LAS __attribute__((address_space(3)))
typedef unsigned short bf16_t;
typedef float f32x4_t __attribute__((ext_vector_type(4)));
typedef float f32x2_t __attribute__((ext_vector_type(2)));
typedef unsigned u32x4_t __attribute__((ext_vector_type(4)));
typedef unsigned u32x2_t __attribute__((ext_vector_type(2)));

constexpr int DM = 2048, NB = 8, SEQ = 2048, CTXL = 256, NLAYER = 2;
constexpr int ML = NB * SEQ, MC = NB * CTXL, MT = ML + MC;
constexpr int INC = 3584, DFF = 5632, SKV = CTXL + SEQ;
constexpr int K_OFF = 1024, V_OFF = 1280, ZM_OFF = 1536, ZX_OFF = 2560, ZG_OFF = 3072;
constexpr int NCHUNK = MT / 128;
constexpr float EPS = 1e-6f;

constexpr size_t SZ_WIN = (size_t)INC * DM * 2, SZ_WOUT = (size_t)DM * DM * 2, SZ_WFI = (size_t)2 * DFF * DM * 2, SZ_WFO = (size_t)DM * DFF * 2;
constexpr size_t SZ_LRUW = (size_t)16 * 128 * 128 * 2, SZ_WSB = (size_t)4 * 128 * 128 * 2, SZ_MOD = (size_t)NLAYER * 9 * 6 * DM * 4;
constexpr size_t WS_WIN = 0;
constexpr size_t WS_WOUT = WS_WIN + NLAYER * SZ_WIN;
constexpr size_t WS_WFI = WS_WOUT + NLAYER * SZ_WOUT;
constexpr size_t WS_WFO = WS_WFI + NLAYER * SZ_WFI;
constexpr size_t WS_LRUW = WS_WFO + NLAYER * SZ_WFO;
constexpr size_t WS_WSB = WS_LRUW + NLAYER * SZ_LRUW;
constexpr size_t WS_MOD = WS_WSB + NLAYER * SZ_WSB;
constexpr size_t WS_HBUF = WS_MOD + SZ_MOD;
constexpr size_t WS_PBUF = WS_HBUF + (size_t)MT * DM * 2;
constexpr size_t WS_YBUF = WS_PBUF + (size_t)MT * DFF * 2;
constexpr size_t WS_YPART = WS_YBUF + (size_t)MT * DM * 2;
constexpr size_t WS_KBUF = WS_YBUF + (size_t)MT * DM * 4;
constexpr size_t WS_VBUF = WS_KBUF + (size_t)NB * 2 * SKV * 128 * 2;
constexpr size_t WS_XC = WS_VBUF + (size_t)NB * 2 * SKV * 128 * 2;
constexpr size_t WS_AGG = WS_XC + (size_t)MC * DM * 4;
constexpr size_t WS_BAR = WS_AGG + (size_t)2 * NCHUNK * 512 * 2 * 4;
constexpr size_t WS_XB = WS_BAR + 16384;
constexpr size_t WS_END = WS_XB + (size_t)MT * DM * 2;
constexpr int LDS_BYTES = 131072 + 64 + 8192;

__device__ __forceinline__ unsigned pk2bf(float lo, float hi) { unsigned r; asm volatile("v_cvt_pk_bf16_f32 %0, %1, %2" : "=v"(r) : "v"(lo), "v"(hi)); return r; }
__device__ __forceinline__ unsigned short f2bf(float f) { return (unsigned short)(pk2bf(f, 0.f) & 0xffffu); }
__device__ __forceinline__ float bf2f(unsigned short b) { return __uint_as_float(((unsigned)b) << 16); }
__device__ __forceinline__ float bflo(unsigned w) { return __uint_as_float(w << 16); }
__device__ __forceinline__ float bfhi(unsigned w) { return __uint_as_float(w & 0xffff0000u); }
__device__ __forceinline__ float sigmoid_f(float x) { return __builtin_amdgcn_rcpf(1.f + __expf(-x)); }
__device__ __forceinline__ float gelu_tanh(float x) { const float u = 1.5957691216057308f * (x + 0.044715f * x * x * x); return x * sigmoid_f(u); }
__device__ __forceinline__ float wave_sum(float v) {
#pragma unroll
    for (int o = 1; o < 64; o <<= 1) v += __shfl_xor(v, o);
    return v;
}
#define LDS_WAIT() asm volatile("s_waitcnt lgkmcnt(0)" ::: "memory")

namespace pg8 {
#define PG8_LAS __attribute__((address_space(3)))
typedef unsigned short bf16_t;
typedef short bf16x8 __attribute__((ext_vector_type(8)));
typedef float f32x4 __attribute__((ext_vector_type(4)));
typedef unsigned u32x4 __attribute__((ext_vector_type(4)));
constexpr int BM = 256, BK = 64, HALF = 128, HTB = HALF * BK * 2  , STAGE_BYTES = 8 * HTB, NXCD = 8, WGM = 8;

__host__ __device__ __forceinline__ int lds_byte(int r, int c) { const int st = (r >> 4) * 2 + (c >> 5), rr = r & 15, cc = c & 31, ob = rr * 64 + cc * 2; return st * 1024 + (ob ^ (((ob >> 9) & 1) << 5)); }
__host__ __device__ __forceinline__ void stage_rc(int b, int& R, int& C) { const int st = b / 1024, sb = b % 1024, swz = sb ^ (((sb >> 9) & 1) << 5); R = (st >> 1) * 16 + swz / 64; C = (st & 1) * 32 + (swz % 64) / 2; }
__host__ __device__ __forceinline__ int perm32(int rho) { const int n = rho >> 4, i = rho & 15; return 8 * (i >> 2) + 4 * n + (i & 3); }

struct Unit { int pm, pn, ks; };
struct Gemm { const bf16_t* A; const bf16_t* Bt; int M, N, K, ld; };

struct StaticOrder {
    int nM, nN, nwg, G, c;
    __host__ __device__ void init(int M, int N, int G_, int c_) { nM = M / BM; nN = N / BM; nwg = nM * nN; G = G_; c = c_; }
    __host__ __device__ bool next(int i, Unit& u) const {
        const long L = (long)i * G + c; if (L >= nwg) return false;
        int wgid = (int)L; { const int q = nwg / NXCD, r = nwg % NXCD, xcd = wgid % NXCD, off = wgid / NXCD; wgid = (xcd < r ? xcd * (q + 1) : r * (q + 1) + (xcd - r) * q) + off; }
        const int nig = WGM * nN, gid = wgid / nig, fm = gid * WGM, gsz = (nM - fm) < WGM ? (nM - fm) : WGM;
        u.pm = fm + ((wgid % nig) % gsz); u.pn = (wgid % nig) / gsz; u.ks = 0; return true;
    }
    __device__ __forceinline__ void a_ready(const Unit&) const {}
    __device__ __forceinline__ void done(const Unit&) const {}
};
struct SplitOrder {
    int nM, nN, NS, G, c;
    __host__ __device__ void init(int M, int N, int NS_, int G_, int c_) { nM = M / BM; nN = N / BM; NS = NS_; G = G_; c = c_; }
    __host__ __device__ bool next(int i, Unit& u) const {
        const long L = (long)i * G + c; if (L >= (long)nM * nN * NS) return false;
        const int ks = (int)(L % NS), tile = (int)(L / NS); u.pm = tile % nM; u.pn = tile / nM; u.ks = ks; return true;
    }
    __device__ __forceinline__ void a_ready(const Unit&) const {}
    __device__ __forceinline__ void done(const Unit&) const {}
};
__device__ __forceinline__ unsigned cvt_pk_bf16(float lo, float hi) { unsigned r; asm volatile("v_cvt_pk_bf16_f32 %0, %1, %2" : "=v"(r) : "v"(lo), "v"(hi)); return r; }
struct EpiF32 {
    static constexpr bool PERM = false, AFTER_DRAIN = false;
    float* C; int ldc;
    __device__ __forceinline__ void operator()(const f32x4 (&acc)[2][2][4][2], const Unit& u, int wr, int wc, int fr, int fq) const {
        const int row0 = u.pm * BM + wr * 64 + fr, col0 = u.pn * BM + wc * 32 + 4 * fq;
#pragma unroll
        for (int ai = 0; ai < 2; ++ai)
#pragma unroll
            for (int m = 0; m < 4; ++m) { float* rowp = C + (size_t)(row0 + ai * HALF + m * 16) * ldc + col0;
#pragma unroll
                for (int bj = 0; bj < 2; ++bj)
#pragma unroll
                    for (int n = 0; n < 2; ++n) *(f32x4*)(rowp + bj * HALF + n * 16) = acc[ai][bj][m][n]; }
    }
};
struct EpiBf16 {
    static constexpr bool PERM = true, AFTER_DRAIN = false;
    bf16_t* O; int ldc;
    __device__ __forceinline__ void operator()(const f32x4 (&acc)[2][2][4][2], const Unit& u, int wr, int wc, int fr, int fq) const {
        const int row0 = u.pm * BM + wr * 64 + fr, col0 = u.pn * BM + wc * 32 + 8 * fq;
#pragma unroll
        for (int ai = 0; ai < 2; ++ai)
#pragma unroll
            for (int m = 0; m < 4; ++m) { bf16_t* rowp = O + (size_t)(row0 + ai * HALF + m * 16) * ldc + col0;
#pragma unroll
                for (int bj = 0; bj < 2; ++bj) { const f32x4 v0 = acc[ai][bj][m][0], v1 = acc[ai][bj][m][1];
                    u32x4 w; w.x = cvt_pk_bf16(v0[0], v0[1]); w.y = cvt_pk_bf16(v0[2], v0[3]); w.z = cvt_pk_bf16(v1[0], v1[1]); w.w = cvt_pk_bf16(v1[2], v1[3]);
                    *(u32x4*)(rowp + bj * HALF) = w; } }
    }
};
struct EpiSwiglu {
    static constexpr bool PERM = true, AFTER_DRAIN = false;
    bf16_t* O; int ldc;
    __device__ __forceinline__ void operator()(const f32x4 (&acc)[2][2][4][2], const Unit& u, int wr, int wc, int fr, int fq) const {
        const int row0 = u.pm * BM + wr * 64 + fr, col0 = u.pn * HALF + wc * 32 + 8 * fq;
#pragma unroll
        for (int ai = 0; ai < 2; ++ai)
#pragma unroll
            for (int m = 0; m < 4; ++m) { bf16_t* rowp = O + (size_t)(row0 + ai * HALF + m * 16) * ldc + col0;
                float v[8];
#pragma unroll
                for (int n = 0; n < 2; ++n)
#pragma unroll
                    for (int j = 0; j < 4; ++j) { const float g = acc[ai][0][m][n][j], uu = acc[ai][1][m][n][j];
                        v[n * 4 + j] = g * __builtin_amdgcn_rcpf(1.f + __expf(-g)) * uu; }
                u32x4 w; w.x = cvt_pk_bf16(v[0], v[1]); w.y = cvt_pk_bf16(v[2], v[3]); w.z = cvt_pk_bf16(v[4], v[5]); w.w = cvt_pk_bf16(v[6], v[7]);
                *(u32x4*)rowp = w; }
    }
};
struct EpiF32Split {
    static constexpr bool PERM = false, AFTER_DRAIN = false;
    float* C; int ldc; size_t split_stride;
    __device__ __forceinline__ void operator()(const f32x4 (&acc)[2][2][4][2], const Unit& u, int wr, int wc, int fr, int fq) const {
        const int row0 = u.pm * BM + wr * 64 + fr, col0 = u.pn * BM + wc * 32 + 4 * fq; float* Cb = C + (size_t)u.ks * split_stride;
#pragma unroll
        for (int ai = 0; ai < 2; ++ai)
#pragma unroll
            for (int m = 0; m < 4; ++m) { float* rowp = Cb + (size_t)(row0 + ai * HALF + m * 16) * ldc + col0;
#pragma unroll
                for (int bj = 0; bj < 2; ++bj)
#pragma unroll
                    for (int n = 0; n < 2; ++n) *(f32x4*)(rowp + bj * HALF + n * 16) = acc[ai][bj][m][n]; }
    }
};
struct EpiBf16Split {
    static constexpr bool PERM = true, AFTER_DRAIN = false;
    bf16_t* O; int ldc; size_t split_stride;
    __device__ __forceinline__ void operator()(const f32x4 (&acc)[2][2][4][2], const Unit& u, int wr, int wc, int fr, int fq) const {
        const int row0 = u.pm * BM + wr * 64 + fr, col0 = u.pn * BM + wc * 32 + 8 * fq; bf16_t* Ob = O + (size_t)u.ks * split_stride;
#pragma unroll
        for (int ai = 0; ai < 2; ++ai)
#pragma unroll
            for (int m = 0; m < 4; ++m) { bf16_t* rowp = Ob + (size_t)(row0 + ai * HALF + m * 16) * ldc + col0;
#pragma unroll
                for (int bj = 0; bj < 2; ++bj) { const f32x4 v0 = acc[ai][bj][m][0], v1 = acc[ai][bj][m][1];
                    u32x4 w; w.x = cvt_pk_bf16(v0[0], v0[1]); w.y = cvt_pk_bf16(v0[2], v0[3]); w.z = cvt_pk_bf16(v1[0], v1[1]); w.w = cvt_pk_bf16(v1[2], v1[3]);
                    *(u32x4*)(rowp + bj * HALF) = w; } }
    }
};
template <class Epi, class Sched, bool STAMP = false>
__device__ __forceinline__ void gemm_phase(PG8_LAS unsigned char* lds, const Gemm g, const Sched& S, const Epi& E, unsigned long long* stamps) {
    int tid_o = threadIdx.x; asm volatile("" : "+v"(tid_o));
    const int tid = tid_o, wid = __builtin_amdgcn_readfirstlane(tid >> 6), lane = tid & 63, wr = wid >> 2, wc = wid & 3, fr = lane & 15, fq = lane >> 4;
    const int K = g.K, nt = K / BK, LD = g.ld;
    int ts_lo = 0, ts_hi = 0, nts = 0; const unsigned long long rt_entry = STAMP ? (unsigned long long)wall_clock64() : 0ull;
#define PG8_STAMP() do { if (STAMP && wid == 0 && nts < 64) { const unsigned long long _c = (unsigned long long)clock64(); \
        ts_lo = (lane == nts) ? (int)(unsigned)_c : ts_lo; ts_hi = (lane == nts) ? (int)(unsigned)(_c >> 32) : ts_hi; ++nts; } } while (0)
    PG8_STAMP();
    unsigned voffA[2], voffB[2];
#pragma unroll
    for (int i = 0; i < 2; ++i) { int R, C; stage_rc(tid * 16 + i * 8192, R, C); const int Rb = Epi::PERM ? ((R & ~31) + perm32(R & 31)) : R;
        voffA[i] = (unsigned)(R * LD + C) * 2u; voffB[i] = (unsigned)(Rb * LD + C) * 2u; }
    const size_t kstep = (size_t)(BK * 2);
    const size_t hstep = (size_t)HALF * LD * 2;
    const size_t tstep = 2 * hstep;
    const unsigned ldsw = (unsigned)wid * 1024u;
    const int aoff = lds_byte(wr * 64 + fr, fq * 8), boff = lds_byte(wc * 32 + fr, fq * 8);
#define PG8_SA(b, h) (((b) * 2 + (h)) * HTB)
#define PG8_SB(b, h) ((4 + (b) * 2 + (h)) * HTB)
#define PG8_STAGE(bufoff, gbase, voff) do { _Pragma("unroll") for (int _i = 0; _i < 2; ++_i) \
        __builtin_amdgcn_global_load_lds((const unsigned*)((const char*)(gbase) + (voff)[_i]), (PG8_LAS unsigned*)(lds + (bufoff) + ldsw + _i * 8192), 16, 0, 0); } while (0)
#define PG8_LDA(dst, b, h) do { _Pragma("unroll") for (int m = 0; m < 4; ++m) _Pragma("unroll") for (int k = 0; k < 2; ++k) dst[m][k] = *(const PG8_LAS bf16x8*)(lds + PG8_SA(b, h) + aoff + m * 2048 + k * 1024); } while (0)
#define PG8_LDB(dst, b, h) do { _Pragma("unroll") for (int n = 0; n < 2; ++n) _Pragma("unroll") for (int k = 0; k < 2; ++k) dst[n][k] = *(const PG8_LAS bf16x8*)(lds + PG8_SB(b, h) + boff + n * 2048 + k * 1024); } while (0)
#define PG8_MMA(ai, bj, At, Bt) do { __builtin_amdgcn_s_setprio(1); _Pragma("unroll") for (int m = 0; m < 4; ++m) _Pragma("unroll") for (int n = 0; n < 2; ++n) _Pragma("unroll") for (int k = 0; k < 2; ++k) \
        acc[ai][bj][m][n] = __builtin_amdgcn_mfma_f32_16x16x32_bf16(Bt[n][k], At[m][k], acc[ai][bj][m][n], 0, 0, 0); __builtin_amdgcn_s_setprio(0); } while (0)
#define PG8_WAIT_V(n) asm volatile("s_waitcnt vmcnt(" #n ")" ::: "memory")
#define PG8_WAIT_L(n) asm volatile("s_waitcnt lgkmcnt(" #n ")" ::: "memory")
#define PG8_BAR __builtin_amdgcn_s_barrier()
#define PG8_SCHED __builtin_amdgcn_sched_barrier(0)
    Unit cur, nxt; int ui = 0;
    if (!S.next(0, cur)) return;
    f32x4 acc[2][2][4][2];
#pragma unroll
    for (int a = 0; a < 2; ++a)
#pragma unroll
        for (int b = 0; b < 2; ++b)
#pragma unroll
            for (int m = 0; m < 4; ++m)
#pragma unroll
                for (int n = 0; n < 2; ++n) acc[a][b][m][n] = (f32x4){0.f, 0.f, 0.f, 0.f};
    bf16x8 At[4][2], B0[2][2], B1[2][2];
    const size_t ksb = (size_t)K * 2;
    const char* cA = (const char*)g.A + (size_t)cur.pm * tstep + (size_t)cur.ks * ksb; const char* cB = (const char*)g.Bt + (size_t)cur.pn * tstep + (size_t)cur.ks * ksb;
    S.a_ready(cur);
    PG8_STAGE(PG8_SB(0, 0), cB, voffB); PG8_STAGE(PG8_SA(0, 0), cA, voffA); PG8_STAGE(PG8_SB(0, 1), cB + hstep, voffB); PG8_STAGE(PG8_SA(0, 1), cA + hstep, voffA);
    if (wr == 1) PG8_BAR;
    PG8_WAIT_V(4); PG8_BAR;
    PG8_STAGE(PG8_SB(1, 0), cB + kstep, voffB); PG8_STAGE(PG8_SA(1, 0), cA + kstep, voffA); PG8_STAGE(PG8_SB(1, 1), cB + hstep + kstep, voffB);
    PG8_WAIT_V(6); PG8_BAR;
    PG8_STAMP();
    for (;;) {
        const bool has_next = S.next(ui + 1, nxt);
        const char* nA = has_next ? (const char*)g.A + (size_t)nxt.pm * tstep + (size_t)nxt.ks * ksb : cA; const char* nB = has_next ? (const char*)g.Bt + (size_t)nxt.pn * tstep + (size_t)nxt.ks * ksb : cB;
        for (int t = 0; t < nt; t += 2) {
            const bool last = (t == nt - 2);
            const char* a1 = cA + (size_t)(t + 1) * kstep;
            const char* a2 = last ? nA : cA + (size_t)(t + 2) * kstep; const char* b2 = last ? nB : cB + (size_t)(t + 2) * kstep;
            const char* a3 = a2 + kstep; const char* b3 = b2 + kstep;
            if (last && has_next) S.a_ready(nxt);
            PG8_LDB(B0, 0, 0); PG8_SCHED; PG8_LDA(At, 0, 0); PG8_STAGE(PG8_SA(1, 1), a1 + hstep, voffA);
            PG8_WAIT_L(8); PG8_BAR; PG8_WAIT_L(0); PG8_MMA(0, 0, At, B0); PG8_BAR; PG8_SCHED;
            PG8_LDB(B1, 0, 1); PG8_STAGE(PG8_SB(0, 0), b2, voffB);
            PG8_BAR; PG8_WAIT_L(0); PG8_MMA(0, 1, At, B1); PG8_BAR;
            PG8_LDA(At, 0, 1); PG8_STAGE(PG8_SA(0, 0), a2, voffA);
            PG8_BAR; PG8_WAIT_L(0); PG8_MMA(1, 0, At, B0); PG8_BAR; PG8_SCHED;
            PG8_STAGE(PG8_SB(0, 1), b2 + hstep, voffB);
            PG8_WAIT_V(6); PG8_BAR; PG8_MMA(1, 1, At, B1); PG8_BAR;
            PG8_LDB(B0, 1, 0); PG8_SCHED; PG8_LDA(At, 1, 0); PG8_STAGE(PG8_SA(0, 1), a2 + hstep, voffA);
            PG8_WAIT_L(8); PG8_BAR; PG8_WAIT_L(0); PG8_MMA(0, 0, At, B0); PG8_BAR; PG8_SCHED;
            PG8_LDB(B1, 1, 1); PG8_STAGE(PG8_SB(1, 0), b3, voffB);
            PG8_BAR; PG8_WAIT_L(0); PG8_MMA(0, 1, At, B1); PG8_BAR;
            PG8_LDA(At, 1, 1); PG8_STAGE(PG8_SA(1, 0), a3, voffA);
            PG8_BAR; PG8_WAIT_L(0); PG8_MMA(1, 0, At, B0); PG8_BAR; PG8_SCHED;
            PG8_STAGE(PG8_SB(1, 1), b3 + hstep, voffB);
            PG8_WAIT_V(6); PG8_BAR; PG8_MMA(1, 1, At, B1); PG8_BAR;
        }
        PG8_STAMP();
        if constexpr (!Epi::AFTER_DRAIN) { E(acc, cur, wr, wc, fr, fq); S.done(cur); }
        PG8_STAMP();
        if (!has_next) break;
#pragma unroll
        for (int a = 0; a < 2; ++a)
#pragma unroll
            for (int b = 0; b < 2; ++b)
#pragma unroll
                for (int m = 0; m < 4; ++m)
#pragma unroll
                    for (int n = 0; n < 2; ++n) acc[a][b][m][n] = (f32x4){0.f, 0.f, 0.f, 0.f};
        cur = nxt; cA = nA; cB = nB; ++ui;
    }
    PG8_WAIT_V(0);
    if (wr == 0) PG8_BAR;
    PG8_BAR;
    if constexpr (Epi::AFTER_DRAIN) { E.fused(acc, cur, wr, wc, fr, fq, lds, wid, lane); S.done(cur); }
    PG8_STAMP();
    if (STAMP && wid == 0) { stamps[lane] = lane < nts ? (((unsigned long long)(unsigned)ts_hi << 32) | (unsigned)ts_lo) : 0ull;
        if (lane == 62) stamps[62] = rt_entry; if (lane == 63) stamps[63] = (unsigned long long)wall_clock64(); }
#undef PG8_STAMP
#undef PG8_SA
#undef PG8_SB
#undef PG8_STAGE
#undef PG8_LDA
#undef PG8_LDB
#undef PG8_MMA
#undef PG8_WAIT_V
#undef PG8_WAIT_L
#undef PG8_BAR
#undef PG8_SCHED
}
}

using bf16 = __hip_bfloat16;
constexpr int   D = 128, NW = 8, QBLK = 32, KVBLK = 64;
constexpr float SCALE = 0.088388347648318440f;
constexpr float THR = 8.f;
#ifndef ATT_SDEPTH
#define ATT_SDEPTH 1
#endif
constexpr int SDEPTH = ATT_SDEPTH;
constexpr int LDQ = INC, LDK = 128, LDO = DM;
constexpr size_t SHM_V = KVBLK * D * 2, SHM_K = KVBLK * D * 2, SHM_ATTN = 2 * SHM_V + 2 * SHM_K + NW * 64 * 4;
using bf16x8 = __attribute__((ext_vector_type(8))) short;
using s16x4  = __attribute__((ext_vector_type(4))) short;
using f32x16 = __attribute__((ext_vector_type(16))) float;
using f32x8  = __attribute__((ext_vector_type(8))) float;
using u32x4  = __attribute__((ext_vector_type(4))) unsigned;
#define KSWZ(row, colB) ((row) * 256 + ((colB) ^ (((row) & 7) << 4)))
#define SBAR() __builtin_amdgcn_sched_barrier(0)
__device__ __forceinline__ int crow(int r, int hi) { return (r & 3) + 8 * (r >> 2) + 4 * hi; }
__device__ __forceinline__ unsigned cvtpk(float lo, float hi) {
  unsigned r; asm volatile("v_cvt_pk_bf16_f32 %0, %1, %2" : "=v"(r) : "v"(lo), "v"(hi)); return r;
}
template <typename TIn> struct Stage;
template <> struct Stage<bf16>  { using T = bf16x8;
  __device__ static __forceinline__ T ld8(const bf16* p) { return *reinterpret_cast<const bf16x8*>(p); }
  __device__ static __forceinline__ bf16x8 tobf(T x) { return x; } };
template <> struct Stage<float> { using T = f32x8;
  __device__ static __forceinline__ T ld8(const float* p) { return *reinterpret_cast<const f32x8*>(p); }
  __device__ static __forceinline__ bf16x8 tobf(T x) {
    u32x4 w = {cvtpk(x[0], x[1]), cvtpk(x[2], x[3]), cvtpk(x[4], x[5]), cvtpk(x[6], x[7])}; return *reinterpret_cast<bf16x8*>(&w); } };

__device__ __forceinline__ void partialSM(f32x16& p0, f32x16& p1, float& m_reg, float& mn, float& alpha) {
  constexpr float C = SCALE * 1.4426950408889634f;
  float pmax = p0[0]; for (int r = 1; r < 16; ++r) pmax = fmaxf(pmax, p0[r]); for (int r = 0; r < 16; ++r) pmax = fmaxf(pmax, p1[r]);
  { auto rr = __builtin_amdgcn_permlane32_swap(__float_as_uint(pmax), __float_as_uint(pmax), false, false);
    pmax = fmaxf(__uint_as_float(rr[0]), __uint_as_float(rr[1])); }
  if (__builtin_expect(__all(pmax - m_reg <= THR / SCALE), 1)) { mn = m_reg; alpha = 1.f; }
  else { mn = fmaxf(m_reg, pmax); alpha = __builtin_amdgcn_exp2f((m_reg - mn) * C); m_reg = mn; }
  float mnC = -mn * C;
  for (int r = 0; r < 16; ++r) p0[r] = fmaf(p0[r], C, mnC); for (int r = 0; r < 16; ++r) p1[r] = fmaf(p1[r], C, mnC);
  for (int r = 0; r < 16; ++r) p0[r] = __builtin_amdgcn_exp2f(p0[r]);
}
__device__ __forceinline__ void finishSM(f32x16& p0, f32x16& p1, float alpha, float& l_reg, bf16x8& pa0, bf16x8& pa1, bf16x8& pa2, bf16x8& pa3) {
  for (int r = 0; r < 16; ++r) p1[r] = __builtin_amdgcn_exp2f(p1[r]);
  float ps = 0; for (int r = 0; r < 16; ++r) ps += p0[r]; for (int r = 0; r < 16; ++r) ps += p1[r];
  { auto rr = __builtin_amdgcn_permlane32_swap(__float_as_uint(ps), __float_as_uint(ps), false, false);
    ps = __uint_as_float(rr[0]) + __uint_as_float(rr[1]); }
  l_reg = l_reg * alpha + ps;
#define PK4(P, BASE, OUT) do { unsigned a0 = cvtpk(P[BASE + 0], P[BASE + 1]), a1 = cvtpk(P[BASE + 2], P[BASE + 3]);   \
    unsigned b0 = cvtpk(P[BASE + 4], P[BASE + 5]), b1 = cvtpk(P[BASE + 6], P[BASE + 7]);                              \
    auto r0 = __builtin_amdgcn_permlane32_swap(a0, b0, false, false); auto r1 = __builtin_amdgcn_permlane32_swap(a1, b1, false, false); \
    u32x4 w = {r0[0], r1[0], r0[1], r1[1]}; OUT = *reinterpret_cast<bf16x8*>(&w); } while (0)
  PK4(p0, 0, pa0); PK4(p0, 8, pa1); PK4(p1, 0, pa2); PK4(p1, 8, pa3);
#undef PK4
}
__device__ __forceinline__ void qkt(f32x16& p0, f32x16& p1, const bf16* Ks, const bf16x8* qr, int r32, int hi) {
  p0 = f32x16{}; p1 = f32x16{};
  for (int d0 = 0; d0 < 8; ++d0) { int cb = (d0 * 16 + hi * 8) * 2;
    bf16x8 b0 = *reinterpret_cast<const bf16x8*>((const char*)Ks + KSWZ(r32, cb));
    bf16x8 b1 = *reinterpret_cast<const bf16x8*>((const char*)Ks + KSWZ(32 + r32, cb));
    p0 = __builtin_amdgcn_mfma_f32_32x32x16_bf16(b0, qr[d0], p0, 0, 0, 0);
    p1 = __builtin_amdgcn_mfma_f32_32x32x16_bf16(b1, qr[d0], p1, 0, 0, 0); }
}
__device__ __forceinline__ int v_st(int k, int c) { const int kk = (k & ~0xC) | ((k & 4) << 1) | ((k & 8) >> 1); return ((kk >> 3) * 4 + (c >> 5)) * 512 + ((kk & 7) * 32 + (c & 31)) * 2; }
__device__ __forceinline__ int v_rd_base(int lane) { return ((lane & 3) << 3) | (((lane >> 2) & 3) << 6) | (((lane >> 4) & 1) << 5) | (((lane >> 5) & 1) << 8); }
constexpr int v_rd_off(int d0, int ks, int half) { return d0 * 512 + ks * 4096 + half * 2048; }
template <int OFF> __device__ __forceinline__ s16x4 tr_read(int vb) {
  s16x4 r; asm volatile("ds_read_b64_tr_b16 %0, %1 offset:%2" : "=&v"(r) : "v"(vb), "i"(OFF) : "memory"); return r;
}
template <int D0> __device__ __forceinline__ void pv_one(f32x16& od, int vb, bf16x8 pa0, bf16x8 pa1, bf16x8 pa2, bf16x8 pa3) {
  const s16x4 l0 = tr_read<v_rd_off(D0, 0, 0)>(vb), h0 = tr_read<v_rd_off(D0, 0, 1)>(vb), l1 = tr_read<v_rd_off(D0, 1, 0)>(vb), h1 = tr_read<v_rd_off(D0, 1, 1)>(vb);
  const s16x4 l2 = tr_read<v_rd_off(D0, 2, 0)>(vb), h2 = tr_read<v_rd_off(D0, 2, 1)>(vb), l3 = tr_read<v_rd_off(D0, 3, 0)>(vb), h3 = tr_read<v_rd_off(D0, 3, 1)>(vb);
  asm volatile("s_waitcnt lgkmcnt(0)" ::: "memory"); SBAR();
#define PK(L, H) (bf16x8){L[0], L[1], L[2], L[3], H[0], H[1], H[2], H[3]}
  od = __builtin_amdgcn_mfma_f32_32x32x16_bf16(pa0, PK(l0, h0), od, 0, 0, 0);
  od = __builtin_amdgcn_mfma_f32_32x32x16_bf16(pa1, PK(l1, h1), od, 0, 0, 0);
  od = __builtin_amdgcn_mfma_f32_32x32x16_bf16(pa2, PK(l2, h2), od, 0, 0, 0);
  od = __builtin_amdgcn_mfma_f32_32x32x16_bf16(pa3, PK(l3, h3), od, 0, 0, 0);
#undef PK
}
__device__ __forceinline__ void pv_d0(f32x16* o, int vb, bf16x8 pa0, bf16x8 pa1, bf16x8 pa2, bf16x8 pa3) {
  pv_one<0>(o[0], vb, pa0, pa1, pa2, pa3); pv_one<1>(o[1], vb, pa0, pa1, pa2, pa3); pv_one<2>(o[2], vb, pa0, pa1, pa2, pa3); pv_one<3>(o[3], vb, pa0, pa1, pa2, pa3);
}

template <typename TQ>
__device__ __forceinline__ void attn_dense_body(const TQ* __restrict__ Qb, const bf16* __restrict__ Kh, const bf16* __restrict__ Vh,
                                                unsigned short* __restrict__ Ob, int seq, char* lds, const float* __restrict__ gq, int tok0) {
  using St = Stage<bf16>; using SQ = Stage<TQ>;
  int tid_o = threadIdx.x; asm volatile("" : "+v"(tid_o));
  const int tid = tid_o, wid = tid >> 6, lane = tid & 63, r32 = lane & 31, hi = lane >> 5;
  bf16* V_lds = (bf16*)lds; bf16* K_lds = (bf16*)(lds + 2 * SHM_V);
  float* ws = (float*)(lds + 2 * SHM_V + 2 * SHM_K) + wid * 64; float* li_l = ws; float* al_l = ws + 32;
  float m_reg = -1e30f, l_reg = 0; f32x16 o[4] = {}; bf16x8 qr[8];
  const TQ* Qw = Qb + (long)(wid * QBLK + r32) * LDQ + hi * 8;
#ifdef ATT_QFUSE
  { float xq[8][8];
#pragma unroll
    for (int d0 = 0; d0 < 8; ++d0) { const u32x4 w = *reinterpret_cast<const u32x4*>(Qw + d0 * 16);
      xq[d0][0] = __uint_as_float(w[0] << 16); xq[d0][1] = __uint_as_float(w[0] & 0xffff0000u); xq[d0][2] = __uint_as_float(w[1] << 16); xq[d0][3] = __uint_as_float(w[1] & 0xffff0000u);
      xq[d0][4] = __uint_as_float(w[2] << 16); xq[d0][5] = __uint_as_float(w[2] & 0xffff0000u); xq[d0][6] = __uint_as_float(w[3] << 16); xq[d0][7] = __uint_as_float(w[3] & 0xffff0000u); }
    float ss = 0.f;
#pragma unroll
    for (int d0 = 0; d0 < 8; ++d0)
#pragma unroll
      for (int e = 0; e < 8; ++e) ss += xq[d0][e] * xq[d0][e];
    ss += __shfl_xor(ss, 32);
    const float rs = rsqrtf(ss * (1.f / 128.f) + 1e-6f);
#pragma unroll
    for (int d0 = 0; d0 < 8; ++d0) { const float* gp = gq + d0 * 16 + hi * 8;
#pragma unroll
      for (int e = 0; e < 8; ++e) xq[d0][e] *= rs * gp[e]; }
    if (tok0 >= 0) { const int n = tok0 + wid * QBLK + r32;
#pragma unroll
      for (int a = 0; a < 2; ++a) { const float pos = (float)(a == 0 ? (n >> 6) : (n & 63));
#pragma unroll
        for (int dd = 0; dd < 2; ++dd)
#pragma unroll
          for (int e = 0; e < 8; ++e) { const int i = dd * 16 + hi * 8 + e;
            const float ang = pos * exp2f(-(float)(2 * i) * (13.287712379549449f / 64.f)); const float kf = rintf(ang * 0.15915494309189535f);
            float rr = fmaf(-kf, 6.2831854820251465f, ang); rr = fmaf(-kf, -1.7484555e-7f, rr); const float cs = __cosf(rr), sn = __sinf(rr);
            const float y0 = xq[a * 4 + dd][e], y1 = xq[a * 4 + 2 + dd][e];
            xq[a * 4 + dd][e] = y0 * cs - y1 * sn; xq[a * 4 + 2 + dd][e] = y1 * cs + y0 * sn; } } }
#pragma unroll
    for (int d0 = 0; d0 < 8; ++d0) { u32x4 w = {cvtpk(xq[d0][0], xq[d0][1]), cvtpk(xq[d0][2], xq[d0][3]), cvtpk(xq[d0][4], xq[d0][5]), cvtpk(xq[d0][6], xq[d0][7])}; qr[d0] = *reinterpret_cast<bf16x8*>(&w); } }
#else
  (void)gq; (void)tok0;
#pragma unroll
  for (int d0 = 0; d0 < 8; ++d0) qr[d0] = SQ::tobf(SQ::ld8(Qw + d0 * 16));
#endif
  const int sr = tid >> 4, sc = (tid & 15) * 8, vst0 = v_st(sr, sc), vst1 = v_st(32 + sr, sc);
  const int vb0 = (int)(uintptr_t)V_lds + v_rd_base(lane);
  struct { typename St::T vs0, vs1, ks0, ks1; } sr_[SDEPTH];
#define SLOAD(i, k0) do { sr_[i].vs0 = St::ld8(&Vh[(long)((k0) + sr) * LDK + sc]); sr_[i].vs1 = St::ld8(&Vh[(long)((k0) + 32 + sr) * LDK + sc]); \
    sr_[i].ks0 = St::ld8(&Kh[(long)((k0) + sr) * LDK + sc]); sr_[i].ks1 = St::ld8(&Kh[(long)((k0) + 32 + sr) * LDK + sc]); } while (0)
#define SWRITE(b, i) do { *(bf16x8*)((char*)V_lds + (b) * SHM_V + vst0) = St::tobf(sr_[i].vs0);          \
    *(bf16x8*)((char*)V_lds + (b) * SHM_V + vst1) = St::tobf(sr_[i].vs1); int kc = sc * 2;               \
    *(bf16x8*)((char*)K_lds + (b) * SHM_K + KSWZ(sr, kc)) = St::tobf(sr_[i].ks0);                       \
    *(bf16x8*)((char*)K_lds + (b) * SHM_K + KSWZ(32 + sr, kc)) = St::tobf(sr_[i].ks1); } while (0)
#define SWAIT() do { if constexpr (SDEPTH == 2) asm volatile("s_waitcnt vmcnt(4)" ::: "memory"); else asm volatile("s_waitcnt vmcnt(0)" ::: "memory"); } while (0)
#define RESC(a) do { if (__any((a) < 1.f)) { if (hi == 0) al_l[r32] = (a); asm volatile("s_waitcnt lgkmcnt(0)" ::: "memory"); \
    for (int d = 0; d < 4; ++d) for (int r = 0; r < 16; ++r) o[d][r] *= al_l[crow(r, hi)]; } } while (0)
  f32x16 pA0, pA1, pB0, pB1; float mnA, mnB, alA, alB; bf16x8 pa0, pa1, pa2, pa3; const int NT = seq / KVBLK;
  constexpr int SE = 0, SO = SDEPTH - 1;
  SLOAD(SE, 0); asm volatile("s_waitcnt vmcnt(0)" ::: "memory"); SWRITE(0, SE); __syncthreads();
  qkt(pA0, pA1, K_lds, qr, r32, hi); partialSM(pA0, pA1, m_reg, mnA, alA);
  SLOAD(SO, KVBLK); if constexpr (SDEPTH == 2) { if (2 < NT) SLOAD(SE, 2 * KVBLK); }
  SWAIT(); SWRITE(1, SO); __syncthreads();
  for (int j = 1; j + 1 < NT; j += 2) {
    SBAR(); qkt(pB0, pB1, (bf16*)((char*)K_lds + SHM_K), qr, r32, hi);
    finishSM(pA0, pA1, alA, l_reg, pa0, pa1, pa2, pa3); SBAR();
    SLOAD(SO, (j + SDEPTH) * KVBLK); SBAR();
    pv_d0(o, vb0, pa0, pa1, pa2, pa3); partialSM(pB0, pB1, m_reg, mnB, alB);
    __syncthreads(); SWAIT(); SWRITE(0, SE);
    RESC(alB); __syncthreads();
    SBAR(); qkt(pA0, pA1, K_lds, qr, r32, hi);
    finishSM(pB0, pB1, alB, l_reg, pa0, pa1, pa2, pa3); SBAR();
    if (SDEPTH == 1 || j + 3 < NT) SLOAD(SE, (j + 1 + SDEPTH) * KVBLK); SBAR();
    pv_d0(o, vb0 + (int)SHM_V, pa0, pa1, pa2, pa3); partialSM(pA0, pA1, m_reg, mnA, alA);
    __syncthreads(); SWAIT(); SWRITE(1, SO);
    RESC(alA); __syncthreads();
  }
  SBAR(); qkt(pB0, pB1, (bf16*)((char*)K_lds + SHM_K), qr, r32, hi);
  finishSM(pA0, pA1, alA, l_reg, pa0, pa1, pa2, pa3); SBAR();
  pv_d0(o, vb0, pa0, pa1, pa2, pa3); partialSM(pB0, pB1, m_reg, mnB, alB);
  __syncthreads(); RESC(alB);
  finishSM(pB0, pB1, alB, l_reg, pa0, pa1, pa2, pa3); SBAR();
  pv_d0(o, vb0 + (int)SHM_V, pa0, pa1, pa2, pa3);
  if (hi == 0) li_l[r32] = l_reg; asm volatile("s_waitcnt lgkmcnt(0)" ::: "memory");
  float rli[16];
#pragma unroll
  for (int r = 0; r < 16; ++r) rli[r] = __builtin_amdgcn_rcpf(li_l[crow(r, hi)]);
  unsigned short* Ow = Ob + (long)(wid * QBLK) * LDO;
#pragma unroll
  for (int r = 0; r < 16; ++r) { int orow = crow(r, hi);
    for (int d0 = 0; d0 < 4; ++d0) Ow[(long)orow * LDO + d0 * 32 + r32] = f2bf(o[d0][r] * rli[r]); }
#undef SLOAD
#undef SWRITE
#undef SWAIT
#undef RESC
}

#define XB_TMO      128
#define XB_XCNT(j)  (256  + 64 * (j))
#define XB_XSUB(j)  (1280 + 64 * (j))
#define XB_XGEN(j)  (2304 + 64 * (j))
#define XB_TOP      3328
#define XB_TOPGEN   3392
#define XCD_BAR_WORDS 3456
#define XB_SPIN_CAP (1u << 18)

__device__ __forceinline__ unsigned xb_ld(unsigned* p)              { return __hip_atomic_load(p, __ATOMIC_RELAXED, __HIP_MEMORY_SCOPE_AGENT); }
__device__ __forceinline__ unsigned xb_add(unsigned* p, unsigned v) { return __hip_atomic_fetch_add(p, v, __ATOMIC_RELAXED, __HIP_MEMORY_SCOPE_AGENT); }
__device__ __forceinline__ unsigned xb_xcc_id() { return (unsigned)__builtin_amdgcn_s_getreg((3 << 11) | 20) & 0xFu; }
#define XB_SPIN(cond, bar) do { unsigned _sp = 0; while (cond) { __builtin_amdgcn_s_sleep(1); \
    if ((++_sp & 255u) == 0u) { if (xb_ld(&(bar)[XB_TMO])) break; if (_sp > XB_SPIN_CAP) { atomicAdd(&(bar)[XB_TMO], 1u); break; } } } } while (0)

struct XcdBarrier {
    unsigned* bar; unsigned x;
    volatile LAS unsigned* st;
};

__device__ __forceinline__ XcdBarrier xcd_barrier_post(unsigned* bar, volatile LAS unsigned* st) {
    XcdBarrier b; b.bar = bar; b.x = xb_xcc_id(); b.st = st;
    if (threadIdx.x == 0) (void)xb_add(&bar[XB_XCNT(b.x)], 1u);
    return b;
}
__device__ __forceinline__ void xcd_barrier_complete(unsigned* bar, unsigned x, unsigned& nloc, unsigned& nx) {
    const unsigned G = gridDim.x * gridDim.y * gridDim.z;
    unsigned sum, cnt, mine, sp = 0u;
    for (;;) {
        sum = 0u; cnt = 0u; mine = 0u;
#pragma unroll
        for (unsigned j = 0; j < 16; ++j) { const unsigned c = xb_ld(&bar[XB_XCNT(j)]); sum += c; cnt += (c > 0u) ? 1u : 0u; mine = (j == x) ? c : mine; }
        if (sum == G) break;
        __builtin_amdgcn_s_sleep(1);
        if ((++sp & 255u) == 0u) { if (xb_ld(&bar[XB_TMO])) break; if (sp > XB_SPIN_CAP) { atomicAdd(&bar[XB_TMO], 1u); break; } }
    }
    nloc = mine > 0u ? mine : 1u; nx = cnt > 0u ? cnt : 1u;
}

__device__ __forceinline__ void xcd_barrier(const XcdBarrier& b) {
    asm volatile("s_waitcnt vmcnt(0)" ::: "memory");
    __syncthreads();
    if (threadIdx.x == 0) {
        unsigned* bar = b.bar;
        __builtin_amdgcn_s_waitcnt(0);
        unsigned nloc = b.st[0], nx = b.st[1];
        if (nloc == 0u) { xcd_barrier_complete(bar, b.x, nloc, nx); b.st[0] = nloc; b.st[1] = nx; }
        const unsigned old = xb_add(&bar[XB_XSUB(b.x)], 1u);
        const unsigned gen = old / nloc;
        if (old + 1u == (gen + 1u) * nloc) {
            __builtin_amdgcn_fence(__ATOMIC_RELEASE, "agent");
            asm volatile("s_waitcnt vmcnt(0)" ::: "memory");
            const unsigned og = xb_add(&bar[XB_TOP], 1u);
            const unsigned tg = og / nx;
            if (og + 1u == (tg + 1u) * nx) xb_add(&bar[XB_TOPGEN], 1u);
            else XB_SPIN(xb_ld(&bar[XB_TOPGEN]) == tg, bar);
            __builtin_amdgcn_fence(__ATOMIC_ACQUIRE, "agent");
            xb_add(&bar[XB_XGEN(b.x)], 1u);
            asm volatile("s_waitcnt vmcnt(0)" ::: "memory");
        } else {
            XB_SPIN(xb_ld(&bar[XB_XGEN(b.x)]) == gen, bar);
            __builtin_amdgcn_fence(__ATOMIC_ACQUIRE, "agent");
            asm volatile("s_waitcnt vmcnt(0)" ::: "memory");
        }
    }
    __syncthreads();
}

typedef short bf16x8_t __attribute__((ext_vector_type(8)));
struct Params { const float* in[19]; float* out; unsigned char* ws; };
enum { I_X = 0, I_C, I_CTX, I_CCTX, I_WMOD, I_BMOD, I_GNORM, I_WIN, I_GQK, I_WS, I_BS, I_CONVW, I_CONVB, I_LRUW, I_LRUB, I_LRULAM, I_WOUT, I_WFI, I_WFO };

__device__ __forceinline__ void transpose_item(const float* __restrict__ W, int ldw, bf16_t* __restrict__ dst, int ldk, LAS float* scr, int lane, bool stream_out) {
#pragma unroll 8
    for (int i = 0; i < 32; ++i) { const int kk = 2 * i + (lane >> 5); scr[kk * 33 + (lane & 31)] = __builtin_nontemporal_load(W + (size_t)kk * ldw + (lane & 31)); }
    LDS_WAIT();
    const int c = lane & 7;
#pragma unroll
    for (int j = 0; j < 4; ++j) { const int n = (lane >> 3) + 8 * j; const LAS float* s = scr + (8 * c) * 33 + n;
        u32x4_t o; o.x = pk2bf(s[0 * 33], s[1 * 33]); o.y = pk2bf(s[2 * 33], s[3 * 33]); o.z = pk2bf(s[4 * 33], s[5 * 33]); o.w = pk2bf(s[6 * 33], s[7 * 33]);
        if (stream_out) __builtin_nontemporal_store(o, (u32x4_t*)(dst + (size_t)n * ldk + 8 * c));
        else *(u32x4_t*)(dst + (size_t)n * ldk + 8 * c) = o; }
    LDS_WAIT();
}

__device__ __forceinline__ void mod_item(int it, const Params& p, LAS float* lds, int tid_in, int wid, int lane_in) {
    int tid = tid_in; asm volatile("" : "+v"(tid)); const int lane = tid & 63; (void)lane_in;
    const int l = it / 96, cgp = it % 96;
    const float* cv = p.in[I_C]; const float* cc = p.in[I_CCTX];
    for (int e = tid; e < 9 * DM; e += 512) { const int r = e >> 11, k = e & (DM - 1); const float v = r < 8 ? cv[r * DM + k] : cc[k]; lds[k * 12 + r] = v * sigmoid_f(v); }
    __syncthreads();
    const float* W = p.in[I_WMOD] + (size_t)l * DM * (6 * DM) + cgp * 128 + lane * 2;
    float acc[9][2];
#pragma unroll
    for (int r = 0; r < 9; ++r) { acc[r][0] = 0.f; acc[r][1] = 0.f; }
    const int kb = wid * 256;
#pragma unroll 16
    for (int k = 0; k < 256; ++k) {
        const f32x2_t w = __builtin_nontemporal_load((const f32x2_t*)(W + (size_t)(kb + k) * (6 * DM)));
        const LAS float* a = lds + (kb + k) * 12;
        const f32x4_t a0 = *(const LAS f32x4_t*)a, a1 = *(const LAS f32x4_t*)(a + 4); const float a8 = a[8];
        acc[0][0] += a0.x * w.x; acc[0][1] += a0.x * w.y; acc[1][0] += a0.y * w.x; acc[1][1] += a0.y * w.y;
        acc[2][0] += a0.z * w.x; acc[2][1] += a0.z * w.y; acc[3][0] += a0.w * w.x; acc[3][1] += a0.w * w.y;
        acc[4][0] += a1.x * w.x; acc[4][1] += a1.x * w.y; acc[5][0] += a1.y * w.x; acc[5][1] += a1.y * w.y;
        acc[6][0] += a1.z * w.x; acc[6][1] += a1.z * w.y; acc[7][0] += a1.w * w.x; acc[7][1] += a1.w * w.y;
        acc[8][0] += a8 * w.x; acc[8][1] += a8 * w.y;
    }
    __syncthreads();
#pragma unroll
    for (int r = 0; r < 9; ++r) { lds[(wid * 18 + r * 2 + 0) * 64 + lane] = acc[r][0]; lds[(wid * 18 + r * 2 + 1) * 64 + lane] = acc[r][1]; }
    __syncthreads();
    float* MOD = (float*)(p.ws + WS_MOD);
    for (int o = tid; o < 9 * 128; o += 512) { const int r = o >> 7, col = o & 127, q = r * 2 + (col & 1), ls = col >> 1;
        float s = p.in[I_BMOD][l * (6 * DM) + cgp * 128 + col];
#pragma unroll
        for (int w = 0; w < 8; ++w) s += lds[(w * 18 + q) * 64 + ls];
        MOD[(size_t)(l * 9 + r) * (6 * DM) + cgp * 128 + col] = s; }
    __syncthreads();
}

__device__ __forceinline__ void phase0(const Params& p, LAS unsigned char* lds, int tid, int wid, int lane) {
    for (int it = blockIdx.x; it < 192; it += gridDim.x) mod_item(it, p, (LAS float*)lds, tid, wid, lane);
    LAS float* scr = (LAS float*)lds + wid * (64 * 33);
    const int gw = blockIdx.x * 8 + wid, NGW = gridDim.x * 8;
    constexpr int NI_WIN = 32 * 112, NI_WOUT = 32 * 64, NI_WFI = 32 * 352, NI_WFO = 88 * 64, NI_LRU = 128, PL = NI_WIN + NI_WOUT + NI_WFI + NI_WFO + NI_LRU;
    int it0 = gw, itstep = NGW, itend = NLAYER * PL;
    if ((int)gridDim.x > 192) { const int n1 = min(((int)gridDim.x - 192) * 8 * 32, NLAYER * PL);
        if ((int)blockIdx.x >= 192) { it0 = ((int)blockIdx.x - 192) * 8 + wid; itstep = ((int)gridDim.x - 192) * 8; itend = n1; }
        else { it0 = n1 + gw; itstep = 192 * 8; } }
    for (int it = it0; it < itend; it += itstep) {
        const int lq = it / PL; int r = it - lq * PL; const int l = NLAYER - 1 - lq;
        const float* src; bf16_t* dst; int ldw, ldk;
        if (r < NI_WIN) { const int kb = r / 112, nb = r % 112; ldw = INC; ldk = DM;
            src = p.in[I_WIN] + (size_t)l * DM * INC + (size_t)(64 * kb) * INC + 32 * nb;
            dst = (bf16_t*)(p.ws + WS_WIN + l * SZ_WIN) + (size_t)(32 * nb) * DM + 64 * kb; }
        else if ((r -= NI_WIN) < NI_WOUT) { const int kb = r / 64, nb = r % 64; ldw = DM; ldk = DM;
            src = p.in[I_WOUT] + (size_t)l * DM * DM + (size_t)(64 * kb) * DM + 32 * nb;
            dst = (bf16_t*)(p.ws + WS_WOUT + l * SZ_WOUT) + (size_t)(32 * nb) * DM + 64 * kb; }
        else if ((r -= NI_WOUT) < NI_WFI) { const int kb = r / 352, nb = r % 352; ldw = 2 * DFF; ldk = DM;
            const int n0 = 32 * nb, half = n0 / DFF, idx = n0 - half * DFF, drow = (idx >> 7) * 256 + half * 128 + (idx & 127);
            src = p.in[I_WFI] + (size_t)l * DM * 2 * DFF + (size_t)(64 * kb) * (2 * DFF) + n0;
            dst = (bf16_t*)(p.ws + WS_WFI + l * SZ_WFI) + (size_t)drow * DM + 64 * kb; }
        else if ((r -= NI_WFI) < NI_WFO) { const int kb = r / 64, nb = r % 64; ldw = DM; ldk = DFF;
            src = p.in[I_WFO] + (size_t)l * DFF * DM + (size_t)(64 * kb) * DM + 32 * nb;
            dst = (bf16_t*)(p.ws + WS_WFO + l * SZ_WFO) + (size_t)(32 * nb) * DFF + 64 * kb; }
        else { r -= NI_WFO; const int mat = r >> 3, sub = r & 7, kb = sub >> 2, nb = sub & 3; ldw = 128; ldk = 128;
            src = p.in[I_LRUW] + (size_t)(l * 16 + mat) * 16384 + (size_t)(64 * kb) * 128 + 32 * nb;
            dst = (bf16_t*)(p.ws + WS_LRUW + l * SZ_LRUW) + (size_t)mat * 16384 + (size_t)(32 * nb) * 128 + 64 * kb; }
        transpose_item(src, ldw, dst, ldk, scr, lane, l != 0);
    }
    bf16_t* WSB = (bf16_t*)(p.ws + WS_WSB);
    for (int i = blockIdx.x * 512 + tid; i < NLAYER * 4 * 128 * 128; i += gridDim.x * 512) WSB[i] = f2bf(p.in[I_WS][i]);
}

__device__ __forceinline__ void load_row(const float* rp, int lane, f32x4_t (&v)[8]) {
    const f32x4_t* q = (const f32x4_t*)rp + lane;
#pragma unroll
    for (int j = 0; j < 8; ++j) v[j] = __builtin_nontemporal_load(q + 64 * j);
}
__device__ __forceinline__ float row_rstd(const f32x4_t (&v)[8]) {
    float s = 0.f;
#pragma unroll
    for (int j = 0; j < 8; ++j) s += (v[j].x * v[j].x + v[j].y * v[j].y) + (v[j].z * v[j].z + v[j].w * v[j].w);
    return rsqrtf(wave_sum(s) * (1.f / DM) + EPS);
}
__device__ __forceinline__ void mod_store(const f32x4_t (&v)[8], float r, const float* g, const float* sh, const float* sc, bf16_t* dst, int lane) {
#pragma unroll
    for (int j = 0; j < 8; ++j) { const int col = 4 * (64 * j + lane);
        const f32x4_t g4 = *(const f32x4_t*)(g + col), sh4 = *(const f32x4_t*)(sh + col), sc4 = *(const f32x4_t*)(sc + col);
        const f32x4_t h = (v[j] * r * g4) * (1.f + sc4) + sh4;
        u32x2_t w; w.x = pk2bf(h.x, h.y); w.y = pk2bf(h.z, h.w);
        *(u32x2_t*)(dst + col) = w; }
}
__device__ __forceinline__ void load_vec8(const float* v, int lane, f32x4_t (&o)[8]) {
#pragma unroll
    for (int j = 0; j < 8; ++j) o[j] = *(const f32x4_t*)(v + 4 * (64 * j + lane));
}
__device__ __forceinline__ void store_h(const f32x4_t (&x)[8], float r, const f32x4_t (&cA)[8], const f32x4_t (&cS)[8], bf16_t* dst, int lane) {
#pragma unroll
    for (int j = 0; j < 8; ++j) { const f32x4_t h = (x[j] * r) * cA[j] + cS[j];
        u32x2_t w; w.x = pk2bf(h.x, h.y); w.y = pk2bf(h.z, h.w);
        *(u32x2_t*)(dst + 4 * (64 * j + lane)) = w; }
}
__device__ __forceinline__ void phaseA(const Params& p, int gw, int NGW, int lane) {
    const float* MOD = (const float*)(p.ws + WS_MOD); bf16_t* H = (bf16_t*)(p.ws + WS_HBUF);
    const int R = (MT + NGW - 1) / NGW; int cur = -1; f32x4_t cA[8], cS[8], v[8], vn[8];
    const int m0 = gw * R;
    if (m0 < MT) load_row(m0 < ML ? p.in[I_X] + (size_t)m0 * DM : p.in[I_CTX] + (size_t)(m0 - ML) * DM, lane, v);
    for (int k = 0; k < R; ++k) { const int m = m0 + k; if (m >= MT) break;
        const int mn = m + 1; const bool has_n = (k + 1 < R) && (mn < MT);
        if (has_n) load_row(mn < ML ? p.in[I_X] + (size_t)mn * DM : p.in[I_CTX] + (size_t)(mn - ML) * DM, lane, vn);
        const bool lat = m < ML; const int bi = lat ? (m >> 11) : 8;
        if (bi != cur) { cur = bi; const float* md = MOD + (size_t)bi * (6 * DM); f32x4_t g[8], sc[8]; load_vec8(p.in[I_GNORM], lane, g); load_vec8(md + DM, lane, sc); load_vec8(md, lane, cS);
#pragma unroll
            for (int j = 0; j < 8; ++j) cA[j] = g[j] * (1.f + sc[j]); }
        store_h(v, row_rstd(v), cA, cS, H + (size_t)m * DM, lane);
        if (has_n) {
#pragma unroll
            for (int j = 0; j < 8; ++j) v[j] = vn[j]; }
    }
}
template <bool XIN32, bool XOUT32>
__device__ __forceinline__ void row_update(const Params& p, int mcount, const float* modl, int gt_off, const float* gy, bool do_next, const float* gnext, const float* modn, int sh_off, int sc_off,
                                           int gw, int NGW, int lane) {
    const bf16_t* Y = (const bf16_t*)(p.ws + WS_YBUF); bf16_t* H = (bf16_t*)(p.ws + WS_HBUF); bf16_t* XB = (bf16_t*)(p.ws + WS_XB);
    const int R = (mcount + NGW - 1) / NGW; int cur = -1; f32x4_t c1[8], cA[8], cS[8];
    bool have_y = false, have_x = false; u32x2_t yn[8], xn[8];
    for (int k = 0; k < R; ++k) { const int m = gw * R + k; if (m >= mcount) break;
        const bool lat = m < ML; const int bi = lat ? (m >> 11) : 8;
        if (bi != cur) { cur = bi; f32x4_t a[8], b[8];
            load_vec8(modl + (size_t)bi * (6 * DM) + gt_off, lane, a); load_vec8(gy, lane, b);
#pragma unroll
            for (int j = 0; j < 8; ++j) c1[j] = a[j] * b[j];
            if (do_next) { const float* mn = modn + (size_t)bi * (6 * DM); load_vec8(gnext, lane, a); load_vec8(mn + sc_off, lane, b); load_vec8(mn + sh_off, lane, cS);
#pragma unroll
                for (int j = 0; j < 8; ++j) cA[j] = a[j] * (1.f + b[j]); } }
        f32x4_t y[8], x[8];
        if (lat) {
            if (!have_y) { const u32x2_t* yq = (const u32x2_t*)(Y + (size_t)m * DM) + lane;
#pragma unroll
                for (int j = 0; j < 8; ++j) yn[j] = __builtin_nontemporal_load(yq + 64 * j); }
#pragma unroll
            for (int j = 0; j < 8; ++j) y[j] = (f32x4_t){bflo(yn[j].x), bfhi(yn[j].x), bflo(yn[j].y), bfhi(yn[j].y)}; }
        else { const u32x2_t* yp = (const u32x2_t*)((const bf16_t*)(p.ws + WS_YPART) + (size_t)(m - ML) * DM) + lane;
          constexpr size_t PS = (size_t)MC * DM / 4;
#pragma unroll
          for (int j = 0; j < 8; ++j) { const u32x2_t a = __builtin_nontemporal_load(yp + 64 * j), b = __builtin_nontemporal_load(yp + 64 * j + PS), c = __builtin_nontemporal_load(yp + 64 * j + 2 * PS), d = __builtin_nontemporal_load(yp + 64 * j + 3 * PS);
              y[j] = ((f32x4_t){bflo(a.x), bfhi(a.x), bflo(a.y), bfhi(a.y)} + (f32x4_t){bflo(b.x), bfhi(b.x), bflo(b.y), bfhi(b.y)})
                   + ((f32x4_t){bflo(c.x), bfhi(c.x), bflo(c.y), bfhi(c.y)} + (f32x4_t){bflo(d.x), bfhi(d.x), bflo(d.y), bfhi(d.y)}); } }
        if (XIN32) load_row(lat ? p.in[I_X] + (size_t)m * DM : p.in[I_CTX] + (size_t)(m - ML) * DM, lane, x);
        else {
            if (!have_x) { const u32x2_t* xq = (const u32x2_t*)(XB + (size_t)m * DM) + lane;
#pragma unroll
                for (int j = 0; j < 8; ++j) xn[j] = __builtin_nontemporal_load(xq + 64 * j); }
#pragma unroll
            for (int j = 0; j < 8; ++j) x[j] = (f32x4_t){bflo(xn[j].x), bfhi(xn[j].x), bflo(xn[j].y), bfhi(xn[j].y)}; }
        { const int mn = m + 1; const bool nx = (k + 1 < R) && (mn < mcount);
          have_y = nx && (mn < ML); have_x = nx && !XIN32;
          if (have_y) { const u32x2_t* yq = (const u32x2_t*)(Y + (size_t)mn * DM) + lane;
#pragma unroll
              for (int j = 0; j < 8; ++j) yn[j] = __builtin_nontemporal_load(yq + 64 * j); }
          if (have_x) { const u32x2_t* xq = (const u32x2_t*)(XB + (size_t)mn * DM) + lane;
#pragma unroll
              for (int j = 0; j < 8; ++j) xn[j] = __builtin_nontemporal_load(xq + 64 * j); } }
        const float ry = row_rstd(y);
#pragma unroll
        for (int j = 0; j < 8; ++j) { x[j] = x[j] + c1[j] * (y[j] * ry);
            if (XOUT32) __builtin_nontemporal_store(x[j], (f32x4_t*)(p.out + (size_t)m * DM + 4 * (64 * j + lane)));
            else { u32x2_t w; w.x = pk2bf(x[j].x, x[j].y); w.y = pk2bf(x[j].z, x[j].w); __builtin_nontemporal_store(w, (u32x2_t*)(XB + (size_t)m * DM + 4 * (64 * j + lane))); } }
        if (do_next) store_h(x, row_rstd(x), cA, cS, H + (size_t)m * DM, lane);
    }
}

#ifdef ATT_QFUSE
#define QK_PS0 2
#else
#define QK_PS0 0
#endif
__device__ __forceinline__ void qk_rows(const Params& p, int l, int gw, int NGW, int lane) {
    bf16_t* P = (bf16_t*)(p.ws + WS_PBUF); bf16_t* KB = (bf16_t*)(p.ws + WS_KBUF); bf16_t* VB = (bf16_t*)(p.ws + WS_VBUF);
    const float* gqk = p.in[I_GQK] + l * 256;
    const int hs = lane >> 4, sub = lane & 15, a = sub >> 3;
    const float sgn = (sub & 4) ? 1.f : -1.f;
    float invf[8], gq[8], gk[8];
#pragma unroll
    for (int e = 0; e < 8; ++e) { const int i = (sub & 3) * 8 + e; invf[e] = exp2f(-(float)(2 * i) * (13.287712379549449f / 64.f)); gq[e] = gqk[sub * 8 + e]; gk[e] = gqk[128 + sub * 8 + e]; }
    u32x4_t w[3];
    if (gw < MT) {
#pragma unroll
        for (int ps = QK_PS0; ps < 3; ++ps) w[ps] = *(const u32x4_t*)(P + (size_t)gw * INC + ps * 512 + lane * 8);
    }
    for (int m = gw; m < MT; m += NGW) {
        u32x4_t wn[3]; const int mn = m + NGW;
        if (mn < MT) {
#pragma unroll
            for (int ps = QK_PS0; ps < 3; ++ps) wn[ps] = *(const u32x4_t*)(P + (size_t)mn * INC + ps * 512 + lane * 8);
        }
        const bool lat = m < ML; int b, keypos; float cs[8], sn[8];
        if (lat) { b = m >> 11; const int n = m & (SEQ - 1); keypos = CTXL + n; const float pos = (float)(a == 0 ? (n >> 6) : (n & 63));
#pragma unroll
            for (int e = 0; e < 8; ++e) { const float ang = pos * invf[e]; const float kf = rintf(ang * 0.15915494309189535f);
                float rr = fmaf(-kf, 6.2831854820251465f, ang); rr = fmaf(-kf, -1.7484555e-7f, rr); cs[e] = __cosf(rr); sn[e] = __sinf(rr); } }
        else { const int mc = m - ML; b = mc >> 8; keypos = mc & (CTXL - 1);
#pragma unroll
            for (int e = 0; e < 8; ++e) { cs[e] = 1.f; sn[e] = 0.f; } }
        bf16_t* pr = P + (size_t)m * INC;
#pragma unroll
        for (int ps = QK_PS0; ps < 3; ++ps) {
            if (ps == 2 && hs >= 2) {
                *(u32x4_t*)(VB + ((size_t)(b * 2 + (hs - 2)) * SKV + keypos) * 128 + sub * 8) = w[ps];
            } else {
                float x[8]; x[0] = bflo(w[ps].x); x[1] = bfhi(w[ps].x); x[2] = bflo(w[ps].y); x[3] = bfhi(w[ps].y); x[4] = bflo(w[ps].z); x[5] = bfhi(w[ps].z); x[6] = bflo(w[ps].w); x[7] = bfhi(w[ps].w);
                float ss = 0.f;
#pragma unroll
                for (int e = 0; e < 8; ++e) ss += x[e] * x[e];
                ss += __shfl_xor(ss, 1); ss += __shfl_xor(ss, 2); ss += __shfl_xor(ss, 4); ss += __shfl_xor(ss, 8);
                const float rs = rsqrtf(ss * (1.f / 128.f) + EPS);
                float o[8];
#pragma unroll
                for (int e = 0; e < 8; ++e) { const float y = x[e] * rs * (ps < 2 ? gq[e] : gk[e]); const float yp = __shfl_xor(y, 4); o[e] = y * cs[e] + sgn * yp * sn[e]; }
                u32x4_t ow; ow.x = pk2bf(o[0], o[1]); ow.y = pk2bf(o[2], o[3]); ow.z = pk2bf(o[4], o[5]); ow.w = pk2bf(o[6], o[7]);
                if (ps < 2) *(u32x4_t*)(pr + ps * 512 + lane * 8) = ow;
                else *(u32x4_t*)(KB + ((size_t)(b * 2 + hs) * SKV + keypos) * 128 + sub * 8) = ow;
            }
        }
#pragma unroll
        for (int ps = QK_PS0; ps < 3; ++ps) w[ps] = wn[ps];
    }
}

constexpr int TS = 136;
__device__ __forceinline__ void tile_mma(f32x4_t (&acc)[8], const LAS bf16_t* X, const LAS bf16_t* Y, int wid, int fr, int fq) {
#pragma unroll
    for (int kk = 0; kk < 4; ++kk) {
        const bf16x8_t av = *(const LAS bf16x8_t*)(X + (16 * wid + fr) * TS + kk * 32 + fq * 8);
#pragma unroll
        for (int jb = 0; jb < 8; ++jb) { const bf16x8_t bv = *(const LAS bf16x8_t*)(Y + (16 * jb + fr) * TS + kk * 32 + fq * 8);
            acc[jb] = __builtin_amdgcn_mfma_f32_16x16x32_bf16(av, bv, acc[jb], 0, 0, 0); }
    }
}
__device__ __forceinline__ void stage_tile(LAS bf16_t* T, const bf16_t* src, int ld, int tid) {
    u32x4_t v[4];
#pragma unroll
    for (int q = 0; q < 4; ++q) { const int idx = tid + 512 * q, row = idx >> 4, c8 = (idx & 15) * 8; v[q] = *(const u32x4_t*)(src + (size_t)row * ld + c8); }
#pragma unroll
    for (int q = 0; q < 4; ++q) { const int idx = tid + 512 * q, row = idx >> 4, c8 = (idx & 15) * 8; *(LAS u32x4_t*)(T + row * TS + c8) = v[q]; }
}

__device__ __forceinline__ void mlp_item(const Params& p, int l, int ck, int g, LAS unsigned char* lds, int tid_in, int wid, int lane_in) {
    int tid = tid_in; asm volatile("" : "+v"(tid)); const int lane = tid & 63; (void)lane_in;
    const bf16_t* P = (const bf16_t*)(p.ws + WS_PBUF); bf16_t* H = (bf16_t*)(p.ws + WS_HBUF);
    LAS bf16_t* X = (LAS bf16_t*)lds; LAS bf16_t* Y = X + 128 * TS;
    const int row0 = ck * 128, fr = lane & 15, fq = lane >> 4;
    u32x4_t vw[2][2], xw[4]; unsigned short uu[4][8]; float bsv[4];
#pragma unroll
    for (int o = 0; o < 2; ++o)
#pragma unroll
        for (int e = 0; e < 2; ++e) vw[o][e] = *(const u32x4_t*)(P + (size_t)(row0 + 2 * lane + e) * INC + (ZM_OFF + 512) + g * 128 + (2 * wid + o) * 8);
    { const bf16_t* src = (const bf16_t*)(p.ws + WS_WSB) + (size_t)(l * 4 + g) * 16384;
#pragma unroll
      for (int q = 0; q < 4; ++q) { const int idx = tid + 512 * q, row = idx >> 4, c8 = (idx & 15) * 8; xw[q] = *(const u32x4_t*)(src + (size_t)row * 128 + c8); } }
    const float* bs = p.in[I_BS] + (l * 4 + g) * 128;
#pragma unroll
    for (int r = 0; r < 4; ++r) { const int pi = 16 * wid + 4 * fq + r; bsv[r] = bs[pi];
        const bf16_t* ur = P + (size_t)(row0 + pi) * INC + ZM_OFF + g * 128;
#pragma unroll
        for (int jb = 0; jb < 8; ++jb) uu[r][jb] = ur[jb * 16 + fr]; }
#pragma unroll
    for (int q = 0; q < 4; ++q) { const int idx = tid + 512 * q, row = idx >> 4, c8 = (idx & 15) * 8; *(LAS u32x4_t*)(X + row * TS + c8) = xw[q]; }
#pragma unroll
    for (int o = 0; o < 2; ++o) { const int c8 = (2 * wid + o) * 8; const u32x4_t a = vw[o][0], b = vw[o][1];
        LAS unsigned* Yd = (LAS unsigned*)(Y + c8 * TS + 2 * lane);
        Yd[0 * (TS / 2)] = pk2bf(gelu_tanh(bflo(a.x)), gelu_tanh(bflo(b.x))); Yd[1 * (TS / 2)] = pk2bf(gelu_tanh(bfhi(a.x)), gelu_tanh(bfhi(b.x)));
        Yd[2 * (TS / 2)] = pk2bf(gelu_tanh(bflo(a.y)), gelu_tanh(bflo(b.y))); Yd[3 * (TS / 2)] = pk2bf(gelu_tanh(bfhi(a.y)), gelu_tanh(bfhi(b.y)));
        Yd[4 * (TS / 2)] = pk2bf(gelu_tanh(bflo(a.z)), gelu_tanh(bflo(b.z))); Yd[5 * (TS / 2)] = pk2bf(gelu_tanh(bfhi(a.z)), gelu_tanh(bfhi(b.z)));
        Yd[6 * (TS / 2)] = pk2bf(gelu_tanh(bflo(a.w)), gelu_tanh(bflo(b.w))); Yd[7 * (TS / 2)] = pk2bf(gelu_tanh(bfhi(a.w)), gelu_tanh(bfhi(b.w))); }
    __syncthreads();
    f32x4_t acc[8];
#pragma unroll
    for (int jb = 0; jb < 8; ++jb) acc[jb] = (f32x4_t){0.f, 0.f, 0.f, 0.f};
    tile_mma(acc, X, Y, wid, fr, fq);
#pragma unroll
    for (int r = 0; r < 4; ++r) { const int pi = 16 * wid + 4 * fq + r;
        bf16_t* orow = H + (size_t)(row0 + pi) * DM + 1024 + g * 128;
#pragma unroll
        for (int jb = 0; jb < 8; ++jb) { const int c = jb * 16 + fr; orow[c] = f2bf(gelu_tanh(bf2f(uu[r][jb])) * (acc[jb][r] + bsv[r])); } }
    __syncthreads();
}

#ifdef PROBE_MASK
#define PROBE_ARGS , unsigned long long& ts_, unsigned long long& tsel_
#define PROBE_PASS , ts_, tsel_
#define ISTAMP(bit) do { const unsigned long long n_ = wall_clock64(); if ((PROBE_MASK) & (1u << (bit))) tsel_ += n_ - ts_; ts_ = n_; } while (0)
#else
#define PROBE_ARGS
#define PROBE_PASS
#define ISTAMP(bit) do {} while (0)
#endif
__device__ __forceinline__ void lru1_item(const Params& p, int l, int ck, int h, int d, LAS unsigned char* lds, int tid_in, int wid, int lane_in PROBE_ARGS) {
    int tid = tid_in; asm volatile("" : "+v"(tid)); const int lane = tid & 63; (void)lane_in;
    const bf16_t* P = (const bf16_t*)(p.ws + WS_PBUF);
    LAS bf16_t* X = (LAS bf16_t*)lds; LAS bf16_t* Y = X + 128 * TS; LAS float* WT = (LAS float*)(lds + 131072 + 64);
    const int fr = lane & 15, fq = lane >> 4;
    int seqbase, L, jc;
    if (ck < 128) { seqbase = (ck >> 4) * SEQ; L = SEQ; jc = ck & 15; } else { const int c2 = ck - 128; seqbase = ML + (c2 >> 1) * CTXL; L = CTXL; jc = c2 & 1; }
    const float* cw = p.in[I_CONVW] + l * 4 * 512 + h * 128; const float* cb = p.in[I_CONVB] + l * 512 + h * 128;
    const bf16_t* LW = (const bf16_t*)(p.ws + WS_LRUW + l * SZ_LRUW);
    const float* lb = p.in[I_LRUB] + (size_t)((l * 2 + d) * 2) * 512 + h * 128; const float* lam = p.in[I_LRULAM] + (l * 2 + d) * 512 + h * 128;
    u32x4_t wga[4], wgx[4];
#pragma unroll
    for (int q = 0; q < 4; ++q) { const int idx = tid + 512 * q, row = idx >> 4, c8 = (idx & 15) * 8;
        wga[q] = *(const u32x4_t*)(LW + (size_t)((d * 2 + 0) * 4 + h) * 16384 + (size_t)row * 128 + c8);
        wgx[q] = *(const u32x4_t*)(LW + (size_t)((d * 2 + 1) * 4 + h) * 16384 + (size_t)row * 128 + c8); }
    {
        const int c8 = (tid & 15) * 8, t0 = tid >> 4;
        f32x4_t w0[4], w1[4];
#pragma unroll
        for (int tap = 0; tap < 4; ++tap) { w0[tap] = *(const f32x4_t*)(cw + tap * 512 + c8); w1[tap] = *(const f32x4_t*)(cw + tap * 512 + c8 + 4); }
        const f32x4_t b0 = *(const f32x4_t*)(cb + c8), b1 = *(const f32x4_t*)(cb + c8 + 4);
#pragma unroll
        for (int hf = 0; hf < 2; ++hf) {
            u32x4_t pw[2][4]; float vm[2][4];
#pragma unroll
            for (int q2 = 0; q2 < 2; ++q2)
#pragma unroll
                for (int tap = 0; tap < 4; ++tap) { const int pos = jc * 128 + t0 + 32 * (2 * hf + q2) + tap - 2, posc = min(max(pos, 0), L - 1);
                    vm[q2][tap] = (pos == posc) ? 1.f : 0.f;
                    pw[q2][tap] = *(const u32x4_t*)(P + (size_t)(seqbase + posc) * INC + ZX_OFF + h * 128 + c8); }
#pragma unroll
            for (int q2 = 0; q2 < 2; ++q2) { f32x4_t x0 = b0, x1 = b1;
#pragma unroll
                for (int tap = 0; tap < 4; ++tap) { const u32x4_t w = pw[q2][tap]; const f32x4_t a0 = w0[tap] * vm[q2][tap], a1 = w1[tap] * vm[q2][tap];
                    x0 += (f32x4_t){bflo(w.x), bfhi(w.x), bflo(w.y), bfhi(w.y)} * a0; x1 += (f32x4_t){bflo(w.z), bfhi(w.z), bflo(w.w), bfhi(w.w)} * a1; }
                u32x4_t o; o.x = pk2bf(x0.x, x0.y); o.y = pk2bf(x0.z, x0.w); o.z = pk2bf(x1.x, x1.y); o.w = pk2bf(x1.z, x1.w);
                *(LAS u32x4_t*)(X + (t0 + 32 * (2 * hf + q2)) * TS + c8) = o; }
        }
    }
    LAS bf16_t* Y2 = Y + 128 * TS;
#pragma unroll
    for (int q = 0; q < 4; ++q) { const int idx = tid + 512 * q, row = idx >> 4, c8 = (idx & 15) * 8; *(LAS u32x4_t*)(Y + row * TS + c8) = wga[q]; *(LAS u32x4_t*)(Y2 + row * TS + c8) = wgx[q]; }
    __syncthreads(); ISTAMP(20);
    float cba[8], cbx[8], clam[8];
#pragma unroll
    for (int jb = 0; jb < 8; ++jb) { const int jj = jb * 16 + fr; cba[jb] = lb[jj]; cbx[jb] = lb[512 + jj]; clam[jb] = lam[jj]; }
    f32x4_t accR[8], accI[8];
#pragma unroll
    for (int jb = 0; jb < 8; ++jb) { accR[jb] = (f32x4_t){0.f, 0.f, 0.f, 0.f}; accI[jb] = (f32x4_t){0.f, 0.f, 0.f, 0.f}; }
    tile_mma(accR, X, Y, wid, fr, fq);
    tile_mma(accI, X, Y2, wid, fr, fq); ISTAMP(21);
    const int src1 = (d == 0 ? lane - 16 : lane + 16) & 63, src2 = (d == 0 ? lane - 32 : lane + 32) & 63;
    const bool v1 = d == 0 ? (fq >= 1) : (fq <= 2), v2 = d == 0 ? (fq >= 2) : (fq <= 1), lastq = d == 0 ? (fq == 3) : (fq == 0);
    float Al[8][4], hl[8][4], Aq[8], hq[8];
#pragma unroll
    for (int jb = 0; jb < 8; ++jb) { const int jj = jb * 16 + fr;
        const float ba = cba[jb], bxb = cbx[jb], sp8 = -8.f * log1pf(expf(-clam[jb]));
        float a4[4], b4[4];
#pragma unroll
        for (int r = 0; r < 4; ++r) {
            const float xv = bf2f(X[(16 * wid + 4 * fq + r) * TS + jj]);
            const float rg = sigmoid_f(accR[jb][r] + ba), ig = sigmoid_f(accI[jb][r] + bxb);
            const float la = sp8 * rg, z = 2.f * la;
            const float om = -z * (1.f + z * (0.5f + z * (0.16666667f + z * (0.041666668f + z * (0.0083333338f + z * 0.0013888889f)))));
            a4[r] = __expf(la); b4[r] = __builtin_amdgcn_sqrtf(om) * (ig * xv); }
        float A, hs;
        if (d == 0) { A = a4[0]; hs = b4[0]; Al[jb][0] = A; hl[jb][0] = hs;
#pragma unroll
            for (int r = 1; r < 4; ++r) { hs = a4[r] * hs + b4[r]; A *= a4[r]; Al[jb][r] = A; hl[jb][r] = hs; } }
        else { A = a4[3]; hs = b4[3]; Al[jb][3] = A; hl[jb][3] = hs;
#pragma unroll
            for (int r = 2; r >= 0; --r) { hs = a4[r] * hs + b4[r]; A *= a4[r]; Al[jb][r] = A; hl[jb][r] = hs; } }
        { const float Ap = __shfl(A, src1), hp = __shfl(hs, src1); if (v1) { hs = A * hp + hs; A = Ap * A; } }
        { const float Ap = __shfl(A, src2), hp = __shfl(hs, src2); if (v2) { hs = A * hp + hs; A = Ap * A; } }
        { const float Ap = __shfl(A, src1), hp = __shfl(hs, src1); Aq[jb] = v1 ? Ap : 1.f; hq[jb] = v1 ? hp : 0.f; }
        if (lastq) { WT[(wid * 128 + jj) * 2 + 0] = A; WT[(wid * 128 + jj) * 2 + 1] = hs; }
    }
    ISTAMP(22); __syncthreads();
    bf16_t* AC = (bf16_t*)(p.ws + WS_YBUF) + (size_t)(d * 2 + 0) * MT * 512; bf16_t* HL = (bf16_t*)(p.ws + WS_YBUF) + (size_t)(d * 2 + 1) * MT * 512;
    LAS float* SA = (LAS float*)lds; LAS float* SB = SA + 16384;
    const bool lastw = d == 0 ? (wid == 7) : (wid == 0);
#pragma unroll
    for (int jb = 0; jb < 8; ++jb) { const int jj = jb * 16 + fr;
        float Aw = 1.f, hw = 0.f;
        f32x2_t wt[8];
#pragma unroll
        for (int w = 0; w < 8; ++w) wt[w] = *(const LAS f32x2_t*)(WT + (w * 128 + jj) * 2);
#pragma unroll
        for (int q = 0; q < 8; ++q) { const int w = d == 0 ? q : 7 - q; const bool use = d == 0 ? (w < wid) : (w > wid);
            const f32x2_t v = d == 0 ? wt[q] : wt[7 - q]; (void)w;
            if (use) { hw = v.x * hw + v.y; Aw *= v.x; } }
        const float PA = Aw * Aq[jb], Ph = Aq[jb] * hw + hq[jb];
#pragma unroll
        for (int r = 0; r < 4; ++r) { const int t = 16 * wid + 4 * fq + r, so = t * 128 + (jj ^ ((fq & 1) << 4));
            const float Ac = PA * Al[jb][r], hc = Al[jb][r] * Ph + hl[jb][r];
            SA[so] = Ac; SB[so] = hc;
            if (lastw && lastq && r == (d == 0 ? 3 : 0)) { float* AG = (float*)(p.ws + WS_AGG) + ((size_t)(d * NCHUNK + ck) * 512 + h * 128 + jj) * 2; AG[0] = Ac; AG[1] = hc; } }
    }
    __syncthreads(); ISTAMP(23);
#pragma unroll
    for (int q8 = 0; q8 < 8; ++q8) { const int idx = tid + 512 * q8, t = idx >> 5, c4 = (idx & 31) * 4, so = t * 128 + (c4 ^ (((t >> 2) & 1) << 4)); const size_t go = (size_t)(ck * 128 + t) * 512 + h * 128 + c4;
        const f32x4_t va = *(const LAS f32x4_t*)(SA + so), vh = *(const LAS f32x4_t*)(SB + so);
        u32x2_t wa, wh; wa.x = pk2bf(va.x, va.y); wa.y = pk2bf(va.z, va.w); wh.x = pk2bf(vh.x, vh.y); wh.y = pk2bf(vh.z, vh.w);
        *(u32x2_t*)(AC + go) = wa; *(u32x2_t*)(HL + go) = wh; }
    __syncthreads();
}

__device__ __forceinline__ void lru2_item(const Params& p, int ck, int h, LAS unsigned char* lds, int tid_in) {
    int tid = tid_in; asm volatile("" : "+v"(tid));
    const bf16_t* P = (const bf16_t*)(p.ws + WS_PBUF); bf16_t* H = (bf16_t*)(p.ws + WS_HBUF);
    LAS float* CR = (LAS float*)lds;
    const bf16_t* Yb = (const bf16_t*)(p.ws + WS_YBUF); const size_t AS = (size_t)MT * 512;
    u32x2_t ra0[8], rh0[8], ra1[8], rh1[8], rzg[8];
#pragma unroll
    for (int q8 = 0; q8 < 8; ++q8) { const int idx = tid + 512 * q8, t = idx >> 5, c4 = (idx & 31) * 4; const size_t row = (size_t)ck * 128 + t, go = row * 512 + h * 128 + c4;
        ra0[q8] = *(const u32x2_t*)(Yb + go); rh0[q8] = *(const u32x2_t*)(Yb + AS + go); ra1[q8] = *(const u32x2_t*)(Yb + 2 * AS + go); rh1[q8] = *(const u32x2_t*)(Yb + 3 * AS + go);
        rzg[q8] = *(const u32x2_t*)(P + row * INC + ZG_OFF + h * 128 + c4); }
    if (tid < 256) { const int d = tid >> 7, j = tid & 127; const float* AG = (const float*)(p.ws + WS_AGG) + (size_t)d * NCHUNK * 1024 + (h * 128 + j) * 2;
        f32x2_t ag[18];
        if (ck < 128) { const int b = ck >> 4, jc = ck & 15, cc0 = 128 + 2 * b;
            ag[0] = *(const f32x2_t*)(AG + (size_t)(d == 0 ? cc0 : cc0 + 1) * 1024); ag[1] = *(const f32x2_t*)(AG + (size_t)(d == 0 ? cc0 + 1 : cc0) * 1024);
#pragma unroll
            for (int q = 0; q < 16; ++q) { const int lq = d == 0 ? q : 15 - q; const bool valid = d == 0 ? (lq < jc) : (lq > jc);
                ag[2 + q] = valid ? *(const f32x2_t*)(AG + (size_t)(b * 16 + lq) * 1024) : (f32x2_t){1.f, 0.f}; } }
        else { const int jc = (ck - 128) & 1; const bool valid = d == 0 ? (jc == 1) : (jc == 0); const int qn = d == 0 ? ck - 1 : ck + 1;
            ag[0] = valid ? *(const f32x2_t*)(AG + (size_t)qn * 1024) : (f32x2_t){1.f, 0.f};
#pragma unroll
            for (int q = 1; q < 18; ++q) ag[q] = (f32x2_t){1.f, 0.f}; }
        float c = 0.f;
#pragma unroll
        for (int q = 0; q < 18; ++q) c = ag[q].x * c + ag[q].y;
        CR[tid] = c; }
    __syncthreads();
#pragma unroll
    for (int q8 = 0; q8 < 8; ++q8) { const int idx = tid + 512 * q8, t = idx >> 5, c4 = (idx & 31) * 4; const size_t row = (size_t)ck * 128 + t;
        const u32x2_t wa0 = ra0[q8], wh0 = rh0[q8], wa1 = ra1[q8], wh1 = rh1[q8];
        const f32x4_t a0 = {bflo(wa0.x), bfhi(wa0.x), bflo(wa0.y), bfhi(wa0.y)}, h0 = {bflo(wh0.x), bfhi(wh0.x), bflo(wh0.y), bfhi(wh0.y)};
        const f32x4_t a1 = {bflo(wa1.x), bfhi(wa1.x), bflo(wa1.y), bfhi(wa1.y)}, h1 = {bflo(wh1.x), bfhi(wh1.x), bflo(wh1.y), bfhi(wh1.y)};
        const f32x4_t c0 = *(const LAS f32x4_t*)(CR + c4), c1 = *(const LAS f32x4_t*)(CR + 128 + c4);
        const u32x2_t zg = rzg[q8];
        const f32x4_t hs = a0 * c0 + h0 + a1 * c1 + h1;
        u32x2_t o; o.x = pk2bf(hs.x * gelu_tanh(bflo(zg.x)), hs.y * gelu_tanh(bfhi(zg.x))); o.y = pk2bf(hs.z * gelu_tanh(bflo(zg.y)), hs.w * gelu_tanh(bfhi(zg.y)));
        *(u32x2_t*)(H + row * DM + 1536 + h * 128 + c4) = o; }
    __syncthreads();
}

typedef const __attribute__((address_space(4))) Params* KParams;
#define PH_BEGIN() KParams kp_ = (KParams)__builtin_amdgcn_kernarg_segment_ptr(); asm volatile("" : "+s"(kp_)); Params p; _Pragma("unroll") for (int i_ = 0; i_ < 19; ++i_) p.in[i_] = kp_->in[i_]; p.out = kp_->out; p.ws = kp_->ws; \
    int tid_o = threadIdx.x; asm volatile("" : "+v"(tid_o)); const int tid = tid_o, wid = __builtin_amdgcn_readfirstlane(tid >> 6), lane = tid & 63, gw = blockIdx.x * 8 + wid; \
    unsigned char* const ws = p.ws; (void)gw; (void)lane; (void)tid; (void)ws
__global__ void __launch_bounds__(512, 2) mega_fwd(Params p_arg) {
    extern __shared__ __attribute__((aligned(16))) unsigned char shm[];
    cg::grid_group grid = cg::this_grid();
    LAS unsigned char* lds = (LAS unsigned char*)shm;
    volatile LAS unsigned* bst = (volatile LAS unsigned*)(lds + 131072);
    if (threadIdx.x == 0) { bst[0] = 0u; bst[1] = 0u; }
    __syncthreads();
    (void)xcd_barrier_post((unsigned*)(p_arg.ws + WS_BAR), bst);
#define GSYNC() do { KParams kq_ = (KParams)__builtin_amdgcn_kernarg_segment_ptr(); asm volatile("" : "+s"(kq_)); XcdBarrier xb_; xb_.bar = (unsigned*)(kq_->ws + WS_BAR); { unsigned x_ = xb_xcc_id(); asm volatile("" : "+s"(x_)); xb_.x = x_; } \
        xb_.st = (volatile LAS unsigned*)((LAS unsigned char*)shm + 131072); xcd_barrier(xb_); } while (0)
    const int G = gridDim.x, NGW = G * 8;
#ifdef PROBE_MASK
    unsigned long long ts_ = wall_clock64(), tsel_ = 0ull;
#define STAMP(bit) do { const unsigned long long n_ = wall_clock64(); if ((PROBE_MASK) & (1u << (bit))) tsel_ += n_ - ts_; ts_ = n_; } while (0)
#else
#define STAMP(bit) do {} while (0)
#endif

#ifndef NO_P0
    { PH_BEGIN(); phase0(p, lds, tid, wid, lane); }
#endif
    if (p_arg.ws == nullptr) grid.sync();
    GSYNC(); STAMP(0);
#ifndef NO_ROWS
    { PH_BEGIN(); phaseA(p, gw, NGW, lane); }
#endif
    GSYNC(); STAMP(1);
#ifdef EXTRA_SYNCS
    for (int i_ = 0; i_ < EXTRA_SYNCS; ++i_) GSYNC();
#endif

#pragma unroll 1
    for (int l = 0; l < NLAYER; ++l) {
        const bool last = (l == NLAYER - 1);
        const int mrows = last ? ML : MT;
#ifndef NO_G1
        { PH_BEGIN(); pg8::StaticOrder S; S.init(MT, INC, G, blockIdx.x); pg8::EpiBf16 E{(bf16_t*)(ws + WS_PBUF), INC};
          pg8::gemm_phase<pg8::EpiBf16, pg8::StaticOrder, false>(lds, pg8::Gemm{(const bf16_t*)(ws + WS_HBUF), (const bf16_t*)(ws + WS_WIN + l * SZ_WIN), MT, INC, DM, DM}, S, E, nullptr); }
#endif
        GSYNC(); STAMP(2);
#ifndef NO_C
        { PH_BEGIN(); const int n_lru = NCHUNK * 8, n_mlp = (last ? 128 : NCHUNK) * 4;
          for (int it = blockIdx.x; it < n_lru + n_mlp; it += G) {
              if (it < n_lru) { lru1_item(p, l, it >> 3, (it >> 1) & 3, it & 1, lds, tid, wid, lane PROBE_PASS); STAMP(10); }
              else { const int r = it - n_lru; mlp_item(p, l, r >> 2, r & 3, lds, tid, wid, lane); STAMP(11); } }
          qk_rows(p, l, gw, NGW, lane); STAMP(12); }
#endif
        GSYNC(); STAMP(3);
#ifndef NO_D
        { PH_BEGIN(); const int n_att = 512 + (last ? 0 : 64), n_l2 = (last ? 128 : NCHUNK) * 4;
          bf16_t* HB = (bf16_t*)(ws + WS_HBUF); const bf16_t* PB = (const bf16_t*)(ws + WS_PBUF);
          for (int it = blockIdx.x; it < n_att + n_l2; it += G) {
              if (it < n_att) {
                  size_t qrow; int b, hq, seq;
                  if (it < 512) { b = it >> 6; hq = (it >> 3) & 7; const int qb = it & 7; qrow = (size_t)b * SEQ + qb * 256; seq = SKV; }
                  else { const int c = it - 512; b = c >> 3; hq = c & 7; qrow = (size_t)ML + b * CTXL; seq = CTXL; }
                  const size_t kvo = (size_t)(b * 2 + (hq >> 2)) * SKV * 128;
                  attn_dense_body<bf16>((const bf16*)(PB + qrow * INC + hq * 128), (const bf16*)((const bf16_t*)(ws + WS_KBUF) + kvo), (const bf16*)((const bf16_t*)(ws + WS_VBUF) + kvo),
                                        HB + qrow * DM + hq * 128, seq, (char*)shm, p.in[I_GQK] + l * 256, it < 512 ? (it & 7) * 256 : -1);
                  __syncthreads(); STAMP(13);
              } else {
#ifndef NO_L2
                  const int r = it - n_att; lru2_item(p, r >> 2, r & 3, lds, tid);
#endif
              } } }
#endif
        GSYNC(); STAMP(4);
#ifndef NO_G2
        { PH_BEGIN(); pg8::StaticOrder S; S.init(ML, DM, G, blockIdx.x); pg8::EpiBf16 E{(bf16_t*)(ws + WS_YBUF), DM};
          pg8::gemm_phase<pg8::EpiBf16, pg8::StaticOrder, false>(lds, pg8::Gemm{(const bf16_t*)(ws + WS_HBUF), (const bf16_t*)(ws + WS_WOUT + l * SZ_WOUT), ML, DM, DM, DM}, S, E, nullptr);
          if (!last) {
              pg8::SplitOrder S2; S2.init(MC, DM, 4, G, blockIdx.x); pg8::EpiBf16Split E2{(bf16_t*)(ws + WS_YPART), DM, (size_t)MC * DM};
              pg8::gemm_phase<pg8::EpiBf16Split, pg8::SplitOrder, false>(lds, pg8::Gemm{(const bf16_t*)(ws + WS_HBUF) + (size_t)ML * DM, (const bf16_t*)(ws + WS_WOUT + l * SZ_WOUT), MC, DM, DM / 4, DM}, S2, E2, nullptr); } }
#endif
        GSYNC(); STAMP(5);
#ifndef NO_ROWS
        { PH_BEGIN(); const float* gn = p.in[I_GNORM] + (size_t)l * 4 * DM; const float* ml = (const float*)(ws + WS_MOD) + (size_t)l * 9 * 6 * DM;
          if (l == 0) row_update<true, false>(p, mrows, ml, 2 * DM, gn + DM, true, gn + 2 * DM, ml, 3 * DM, 4 * DM, gw, NGW, lane);
          else row_update<false, false>(p, mrows, ml, 2 * DM, gn + DM, true, gn + 2 * DM, ml, 3 * DM, 4 * DM, gw, NGW, lane); }
#endif
        GSYNC(); STAMP(6);
#ifndef NO_G3
        { PH_BEGIN(); pg8::StaticOrder S; S.init(mrows, 2 * DFF, G, blockIdx.x); pg8::EpiSwiglu E{(bf16_t*)(ws + WS_PBUF), DFF};
          pg8::gemm_phase<pg8::EpiSwiglu, pg8::StaticOrder, false>(lds, pg8::Gemm{(const bf16_t*)(ws + WS_HBUF), (const bf16_t*)(ws + WS_WFI + l * SZ_WFI), mrows, 2 * DFF, DM, DM}, S, E, nullptr); }
#endif
        GSYNC(); STAMP(7);
#ifndef NO_G4
        { PH_BEGIN(); pg8::StaticOrder S; S.init(ML, DM, G, blockIdx.x); pg8::EpiBf16 E{(bf16_t*)(ws + WS_YBUF), DM};
          pg8::gemm_phase<pg8::EpiBf16, pg8::StaticOrder, false>(lds, pg8::Gemm{(const bf16_t*)(ws + WS_PBUF), (const bf16_t*)(ws + WS_WFO + l * SZ_WFO), ML, DM, DFF, DFF}, S, E, nullptr);
          if (!last) {
              pg8::SplitOrder S2; S2.init(MC, DM, 4, G, blockIdx.x); pg8::EpiBf16Split E2{(bf16_t*)(ws + WS_YPART), DM, (size_t)MC * DM};
              pg8::gemm_phase<pg8::EpiBf16Split, pg8::SplitOrder, false>(lds, pg8::Gemm{(const bf16_t*)(ws + WS_PBUF) + (size_t)ML * DFF, (const bf16_t*)(ws + WS_WFO + l * SZ_WFO), MC, DM, DFF / 4, DFF}, S2, E2, nullptr); } }
#endif
        GSYNC(); STAMP(8);
#ifndef NO_ROWS
        { PH_BEGIN(); const float* gn = p.in[I_GNORM] + (size_t)l * 4 * DM; const float* ml = (const float*)(ws + WS_MOD) + (size_t)l * 9 * 6 * DM;
          const float* gnn = p.in[I_GNORM] + (size_t)(last ? l : l + 1) * 4 * DM; const float* mln = (const float*)(ws + WS_MOD) + (size_t)(last ? l : l + 1) * 9 * 6 * DM;
          if (last) row_update<false, true>(p, mrows, ml, 5 * DM, gn + 3 * DM, false, gnn, mln, 0, DM, gw, NGW, lane);
          else row_update<false, false>(p, mrows, ml, 5 * DM, gn + 3 * DM, true, gnn, mln, 0, DM, gw, NGW, lane); }
#endif
        if (!last) { GSYNC(); STAMP(9); }
    }
#ifdef PROBE_MASK
    GSYNC(); STAMP(9);
    if (blockIdx.x == 0) { const float t_us = (float)tsel_ * 0.01f; const float delta = 0.1f * sqrtf(t_us * (1.f / 5000.f));
        for (int i = threadIdx.x; i < 65536; i += 512) p_arg.out[i] += delta; }
#endif
}

extern "C" void kernel_launch(void* const* d_in, const int* in_sizes, int n_in, void* d_out, int out_size, void* d_ws, size_t ws_size, hipStream_t stream) {
    static int grid_blocks = 0;
    if (grid_blocks == 0) {
        if (n_in != 19 || out_size != ML * DM || ws_size < WS_END) { fprintf(stderr, "kernel_launch: unexpected shapes (n_in %d out %d ws %zu need %zu)\n", n_in, out_size, ws_size, (size_t)WS_END); grid_blocks = -1; return; }
        int dev = 0, cus = 0, per_cu = 0;
        hipGetDevice(&dev);
        hipDeviceGetAttribute(&cus, hipDeviceAttributeMultiprocessorCount, dev);
        if (hipFuncSetAttribute((const void*)mega_fwd, hipFuncAttributeMaxDynamicSharedMemorySize, LDS_BYTES) != hipSuccess) { fprintf(stderr, "kernel_launch: hipFuncSetAttribute failed\n"); grid_blocks = -1; return; }
        if (hipOccupancyMaxActiveBlocksPerMultiprocessor(&per_cu, (const void*)mega_fwd, 512, LDS_BYTES) != hipSuccess || per_cu < 1) { fprintf(stderr, "kernel_launch: occupancy query failed (%d)\n", per_cu); per_cu = 1; }
        (void)hipGetLastError();
        grid_blocks = cus * 1;
    }
    if (grid_blocks < 0) return;
    if (hipMemsetAsync((char*)d_ws + WS_BAR, 0, XCD_BAR_WORDS * 4, stream) != hipSuccess) { fprintf(stderr, "kernel_launch: memset failed\n"); return; }
    Params p{};
    for (int i = 0; i < 19; ++i) p.in[i] = (const float*)d_in[i];
    p.out = (float*)d_out; p.ws = (unsigned char*)d_ws;
    void* args[] = {&p};
    hipError_t e = hipLaunchCooperativeKernel((const void*)mega_fwd, dim3(grid_blocks), dim3(512), args, LDS_BYTES, stream);
    if (e != hipSuccess) fprintf(stderr, "cooperative launch failed: %s (grid %d)\n", hipGetErrorString(e), grid_blocks);
}
```
